# Optimizing an MI355X kernel written in HIP

```python
import jax, jax.numpy as jnp
from jax import lax
import numpy as np

D_MODEL = 2048
BATCH = 2
SEQ = 4096
DEPTH = 1

N_Q_HEADS = 32
N_KV_HEADS = 8
HEAD_DIM = 64
Q_PER_KV = N_Q_HEADS // N_KV_HEADS
WINDOW = 128
ATTN_BLOCK = 128
ROT_DIM = HEAD_DIM // 4
ROPE_THETA = 500000.0
SSD_HEADS = 32
SSD_HEAD_DIM = 64
SSD_INNER = SSD_HEADS * SSD_HEAD_DIM
SSD_GROUPS = 8
SSD_STATE = 128
SSD_CONV = 4
SSD_CHUNK = 128
HEADS_PER_GROUP = SSD_HEADS // SSD_GROUPS
ATTN_WIDTH = N_Q_HEADS * HEAD_DIM
KV_WIDTH = N_KV_HEADS * HEAD_DIM
MIX_WIDTH = ATTN_WIDTH + SSD_INNER
BC_WIDTH = SSD_GROUPS * SSD_STATE
CONV_CH = SSD_INNER + 2 * BC_WIDTH
IN_PROJ_WIDTH = ATTN_WIDTH + 2 * KV_WIDTH + SSD_INNER + CONV_CH + SSD_HEADS
D_FF = 5632
FFN_CONV = 3
EPS = 1e-6

kernel_name = 'hymba_swa_sink_ssd_convffn'


def _rmsnorm(x, g):
    xf = x.astype(jnp.float32)
    y = xf * lax.rsqrt(jnp.mean(xf * xf, axis=-1, keepdims=True) + EPS)
    return (y * g.astype(jnp.float32)).astype(x.dtype)


def _causal_dwconv(x, w, b):
    k_taps = w.shape[0]
    s = x.shape[1]
    xp = jnp.pad(x, ((0, 0), (k_taps - 1, 0), (0, 0)))
    out = b
    for t in range(k_taps):
        out = out + xp[:, t:t + s] * w[t]
    return out


def _partial_rope(x, pos):
    half = ROT_DIM // 2
    inv = 1.0 / (ROPE_THETA ** (jnp.arange(0, ROT_DIM, 2, dtype=jnp.float32) / ROT_DIM))
    ang = pos[:, None] * inv[None, :]
    cos = jnp.cos(ang)[None, :, None, :]
    sin = jnp.sin(ang)[None, :, None, :]
    xf = x.astype(jnp.float32)
    x1 = xf[..., :half]
    x2 = xf[..., half:ROT_DIM]
    out = jnp.concatenate([x1 * cos - x2 * sin, x2 * cos + x1 * sin, xf[..., ROT_DIM:]], axis=-1)
    return out.astype(x.dtype)


def _band_blocks(t):
    b, s, h, d = t.shape
    nb = s // ATTN_BLOCK
    tp = jnp.pad(t, ((0, 0), (ATTN_BLOCK, 0), (0, 0), (0, 0)))
    prev = tp[:, :s].reshape(b, nb, ATTN_BLOCK, h, d)
    cur = t.reshape(b, nb, ATTN_BLOCK, h, d)
    return jnp.concatenate([prev, cur], axis=2)


def _sliding_window_attention(q, k, v, sinks):
    b, s, _, d = q.shape
    nb = s // ATTN_BLOCK
    qb = q.reshape(b, nb, ATTN_BLOCK, N_KV_HEADS, Q_PER_KV, d)
    kb = _band_blocks(k)
    vb = _band_blocks(v)
    scores = jnp.einsum('bnqhgd,bnkhd->bnhgqk', qb, kb, preferred_element_type=jnp.float32) * (d ** -0.5)
    qi = jnp.arange(ATTN_BLOCK)[:, None]
    kj = jnp.arange(2 * ATTN_BLOCK)[None, :]
    rel = qi + ATTN_BLOCK - kj
    band = (rel >= 0) & (rel < WINDOW)
    blk = jnp.arange(nb)[:, None, None]
    valid = band[None] & ((blk > 0) | (kj >= ATTN_BLOCK)[None])
    scores = jnp.where(valid[None, :, None, None], scores, -jnp.inf)
    sink = sinks.astype(jnp.float32).reshape(N_KV_HEADS, Q_PER_KV)[None, None, :, :, None, None]
    m = jnp.maximum(jnp.max(scores, axis=-1, keepdims=True), sink)
    p = jnp.exp(scores - m)
    probs = p / (jnp.sum(p, axis=-1, keepdims=True) + jnp.exp(sink - m))
    out = jnp.einsum('bnhgqk,bnkhd->bnqhgd', probs.astype(v.dtype), vb)
    return out.reshape(b, s, N_Q_HEADS * d)


def _ssd_chunked(xh, dt, a, bm, cm):
    b, s, _, p = xh.shape
    nc = s // SSD_CHUNK
    g, r, n = SSD_GROUPS, HEADS_PER_GROUP, SSD_STATE
    x_c = (xh * dt[..., None]).reshape(b, nc, SSD_CHUNK, g, r, p)
    a_cs = jnp.cumsum((dt * a).reshape(b, nc, SSD_CHUNK, g, r), axis=2)
    b_c = bm.reshape(b, nc, SSD_CHUNK, g, n)
    c_c = cm.reshape(b, nc, SSD_CHUNK, g, n)
    seg = a_cs[:, :, :, None] - a_cs[:, :, None, :]
    causal = jnp.tril(jnp.ones((SSD_CHUNK, SSD_CHUNK), dtype=bool))[None, None, :, :, None, None]
    l_mat = jnp.exp(jnp.where(causal, seg, -jnp.inf))
    cb = jnp.einsum('bclgn,bcsgn->bclsg', c_c, b_c)
    y_diag = jnp.einsum('bclsgr,bcsgrp->bclgrp', cb[..., None] * l_mat, x_c)
    decay_s = jnp.exp(a_cs[:, :, -1:] - a_cs)
    states = jnp.einsum('bcsgn,bcsgrp->bcgrpn', b_c, x_c * decay_s[..., None])
    chunk_decay = jnp.exp(a_cs[:, :, -1])

    def step(h, inp):
        s_c, d_c = inp
        return h * d_c[..., None, None] + s_c, h

    h0 = jnp.zeros((b, g, r, p, n), dtype=jnp.float32)
    _, prev = lax.scan(step, h0, (jnp.moveaxis(states, 1, 0), jnp.moveaxis(chunk_decay, 1, 0)))
    prev = jnp.moveaxis(prev, 0, 1)
    y_off = jnp.einsum('bclgn,bcgrpn->bclgrp', c_c, prev) * jnp.exp(a_cs)[..., None]
    return (y_diag + y_off).reshape(b, s, SSD_HEADS, p)


def _gated_group_rmsnorm(y, z, g):
    b, s, _ = y.shape
    yg = y * jax.nn.silu(z.astype(jnp.float32))
    yr = yg.reshape(b, s, SSD_GROUPS, -1)
    yr = yr * lax.rsqrt(jnp.mean(yr * yr, axis=-1, keepdims=True) + EPS)
    return yr.reshape(b, s, SSD_INNER) * g.astype(jnp.float32)


def _hybrid_mixer(xn, w_in, sinks, attn_out_norm, ssd_conv_w, ssd_conv_b, dt_bias, a_log, ssd_d, ssd_norm, w_out):
    b, s, _ = xn.shape
    proj = xn @ w_in
    o = np.cumsum([0, ATTN_WIDTH, KV_WIDTH, KV_WIDTH, SSD_INNER, CONV_CH, SSD_HEADS])
    q = proj[..., o[0]:o[1]].reshape(b, s, N_Q_HEADS, HEAD_DIM)
    k = proj[..., o[1]:o[2]].reshape(b, s, N_KV_HEADS, HEAD_DIM)
    v = proj[..., o[2]:o[3]].reshape(b, s, N_KV_HEADS, HEAD_DIM)
    z = proj[..., o[3]:o[4]]
    xbc = proj[..., o[4]:o[5]]
    dt_raw = proj[..., o[5]:o[6]]
    pos = jnp.arange(s, dtype=jnp.float32)
    q = _partial_rope(q, pos)
    k = _partial_rope(k, pos)
    attn = _rmsnorm(_sliding_window_attention(q, k, v, sinks), attn_out_norm)
    xbc = jax.nn.silu(_causal_dwconv(xbc, ssd_conv_w, ssd_conv_b)).astype(jnp.float32)
    xs = xbc[..., :SSD_INNER].reshape(b, s, SSD_HEADS, SSD_HEAD_DIM)
    bm = xbc[..., SSD_INNER:SSD_INNER + BC_WIDTH].reshape(b, s, SSD_GROUPS, SSD_STATE)
    cm = xbc[..., SSD_INNER + BC_WIDTH:].reshape(b, s, SSD_GROUPS, SSD_STATE)
    dt = jax.nn.softplus(dt_raw.astype(jnp.float32) + dt_bias.astype(jnp.float32))
    a = -jnp.exp(a_log.astype(jnp.float32))
    y = _ssd_chunked(xs, dt, a, bm, cm) + ssd_d.astype(jnp.float32)[:, None] * xs
    y = _gated_group_rmsnorm(y.reshape(b, s, SSD_INNER), z, ssd_norm).astype(xn.dtype)
    return jnp.concatenate([attn, y], axis=-1) @ w_out


def _conv_ffn(hn, w_up, ffn_conv_w, ffn_conv_b, w_down):
    u = _causal_dwconv(hn @ w_up, ffn_conv_w, ffn_conv_b)
    gate, val = u[..., :D_FF], u[..., D_FF:]
    return (jax.nn.silu(gate) * val) @ w_down


def setup_inputs(seed: int = 0) -> dict:
    key = jax.random.key(seed)
    ks = jax.random.split(key, 20)
    f32 = jnp.float32
    nrm = lambda k, shape, scale: jax.random.normal(k, shape, f32) * scale
    x = jax.random.normal(ks[0], (BATCH, SEQ, D_MODEL), f32)
    dt0 = jnp.exp(jax.random.uniform(ks[8], (DEPTH, SSD_HEADS), f32, np.log(1e-3), np.log(1e-1)))
    return {
        'x': x,
        'norm_mix': 1.0 + nrm(ks[1], (DEPTH, D_MODEL), 0.01),
        'w_in': nrm(ks[2], (DEPTH, D_MODEL, IN_PROJ_WIDTH), D_MODEL ** -0.5),
        'sinks': nrm(ks[3], (DEPTH, N_Q_HEADS), 0.5),
        'attn_out_norm': 1.0 + nrm(ks[4], (DEPTH, ATTN_WIDTH), 0.01),
        'ssd_conv_w': nrm(ks[5], (DEPTH, SSD_CONV, CONV_CH), SSD_CONV ** -0.5),
        'ssd_conv_b': nrm(ks[6], (DEPTH, CONV_CH), 0.01),
        'dt_bias': dt0 + jnp.log(-jnp.expm1(-dt0)),
        'a_log': jnp.log(jax.random.uniform(ks[9], (DEPTH, SSD_HEADS), f32, 1.0, 16.0)),
        'ssd_d': 1.0 + nrm(ks[10], (DEPTH, SSD_HEADS), 0.01),
        'ssd_norm': 1.0 + nrm(ks[11], (DEPTH, SSD_INNER), 0.01),
        'w_out': nrm(ks[12], (DEPTH, MIX_WIDTH, D_MODEL), MIX_WIDTH ** -0.5),
        'norm_ffn': 1.0 + nrm(ks[13], (DEPTH, D_MODEL), 0.01),
        'w_up': nrm(ks[14], (DEPTH, D_MODEL, 2 * D_FF), D_MODEL ** -0.5),
        'ffn_conv_w': nrm(ks[15], (DEPTH, FFN_CONV, 2 * D_FF), FFN_CONV ** -0.5),
        'ffn_conv_b': nrm(ks[16], (DEPTH, 2 * D_FF), 0.01),
        'w_down': nrm(ks[17], (DEPTH, D_FF, D_MODEL), D_FF ** -0.5),
        'norm_final': 1.0 + nrm(ks[18], (D_MODEL,), 0.01),
    }


def reference(x, norm_mix, w_in, sinks, attn_out_norm, ssd_conv_w, ssd_conv_b, dt_bias, a_log, ssd_d, ssd_norm, w_out, norm_ffn, w_up, ffn_conv_w, ffn_conv_b, w_down, norm_final):
    h = x
    for l in range(DEPTH):
        h = h + _hybrid_mixer(_rmsnorm(h, norm_mix[l]), w_in[l], sinks[l], attn_out_norm[l], ssd_conv_w[l], ssd_conv_b[l], dt_bias[l], a_log[l], ssd_d[l], ssd_norm[l], w_out[l])
        h = h + _conv_ffn(_rmsnorm(h, norm_ffn[l]), w_up[l], ffn_conv_w[l], ffn_conv_b[l], w_down[l])
    return _rmsnorm(h, norm_final)
```

```cpp
#include <hip/hip_runtime.h>
#include <hip/hip_cooperative_groups.h>
#include <cstdio>
#include <cstdint>
namespace cg = cooperative_groups;

#define LAS __attribute__((address_space(3)))
typedef unsigned short bf16;
typedef short bf16x8 __attribute__((ext_vector_type(8)));
typedef short s16x4 __attribute__((ext_vector_type(4)));
typedef float f32x4 __attribute__((ext_vector_type(4)));
typedef unsigned u32x4 __attribute__((ext_vector_type(4)));
typedef unsigned u32x2 __attribute__((ext_vector_type(2)));

constexpr int SEQ = 4096, M = 8192, D = 2048;
constexpr int NPROJ = 9472;
constexpr int LDP = 9216;
constexpr int PC_Z = 2048, PC_K = 4096, PC_V = 4608, PC_X = 5120;
constexpr int DFF = 5632, NUP = 11264;
constexpr float EPS = 1e-6f;
constexpr float LOG2E = 1.4426950408889634f;

constexpr size_t MiB = 1u << 20;
constexpr size_t WS_XN = 1 * MiB;
constexpr size_t WS_WIN = 33 * MiB;
constexpr size_t WS_WUP = 1 * MiB, WS_WDOWN = 45 * MiB;
constexpr size_t WS_WOUT = 70 * MiB;
constexpr size_t WS_PROJ = 86 * MiB;
constexpr size_t WS_ACT = 86 * MiB;
constexpr size_t WS_STATES = 230 * MiB;
constexpr size_t WS_H1B = 230 * MiB;
constexpr size_t WS_XCONV = 262 * MiB;
constexpr size_t WS_DTRAW = 326 * MiB;
constexpr size_t WS_DTV = 327 * MiB;
constexpr size_t WS_ACS = 328 * MiB;
constexpr size_t WS_ATTSS = 329 * MiB;
constexpr size_t WS_SS1 = 330 * MiB;
constexpr size_t WS_SS2 = 330 * MiB + 512 * 1024;
constexpr size_t WS_HEAD = 331 * MiB;
constexpr size_t WS_TAIL = 334 * MiB;
constexpr size_t WS_END = 337 * MiB;

constexpr int LDS_BYTES = 147456;
constexpr int LDS_XCH = 131072;
constexpr int LDS_RED = 139264;

__device__ __forceinline__ unsigned f2bf(float f) { unsigned u = __builtin_bit_cast(unsigned, f); return (u + 0x7fffu + ((u >> 16) & 1u)) >> 16; }
typedef float f32x2_t __attribute__((ext_vector_type(2)));
typedef __bf16 bf16x2_t __attribute__((ext_vector_type(2)));
__device__ __forceinline__ unsigned pk2(float lo, float hi) { const f32x2_t v = {lo, hi}; return __builtin_bit_cast(unsigned, __builtin_convertvector(v, bf16x2_t)); }
__device__ __forceinline__ float bflo(unsigned w) { return __builtin_bit_cast(float, w << 16); }
__device__ __forceinline__ float bfhi(unsigned w) { return __builtin_bit_cast(float, w & 0xffff0000u); }
__device__ __forceinline__ float fexp2(float x) { return __builtin_amdgcn_exp2f(x); }
__device__ __forceinline__ float fexp(float x) { return __builtin_amdgcn_exp2f(x * LOG2E); }
__device__ __forceinline__ float frcp(float x) { return __builtin_amdgcn_rcpf(x); }
__device__ __forceinline__ float silu(float v) { return v * frcp(1.0f + fexp(-v)); }
__device__ __forceinline__ float wave_sum(float v) {
#pragma unroll
    for (int o = 1; o < 64; o <<= 1) v += __shfl_xor(v, o);
    return v;
}
__device__ __forceinline__ f32x4 mfma16(bf16x8 a, bf16x8 b, f32x4 c) { return __builtin_amdgcn_mfma_f32_16x16x32_bf16(a, b, c, 0, 0, 0); }
__device__ __forceinline__ s16x4 ldtr(const LAS bf16* p) { return __builtin_amdgcn_ds_read_tr16_b64_v4i16((LAS s16x4*)p); }
__device__ __forceinline__ bf16x8 cat8(s16x4 a, s16x4 b) { return __builtin_shufflevector(a, b, 0, 1, 2, 3, 4, 5, 6, 7); }
__device__ __forceinline__ float ror1(float x) { return __builtin_bit_cast(float, __builtin_amdgcn_update_dpp(0, __builtin_bit_cast(int, x), 0x121, 0xF, 0xF, false)); }
__device__ __forceinline__ float ror2(float x) { return __builtin_bit_cast(float, __builtin_amdgcn_update_dpp(0, __builtin_bit_cast(int, x), 0x122, 0xF, 0xF, false)); }
#define LDS_WAIT() asm volatile("s_waitcnt lgkmcnt(0)" ::: "memory")
#define WG_BAR() do { asm volatile("s_waitcnt lgkmcnt(0)" ::: "memory"); __builtin_amdgcn_s_barrier(); asm volatile("" ::: "memory"); } while (0)

__device__ __forceinline__ float rope_rev(int i) {
    return i == 0 ? 0.15915494309189535f : i == 1 ? 0.03086376340470123f : i == 2 ? 0.005985185712713705f : i == 3 ? 0.001160663641240061f :
           i == 4 ? 0.00022507907903927653f : i == 5 ? 4.364795279280289e-05f : i == 6 ? 8.464330808241401e-06f : 1.6414262627950345e-06f;
}
__device__ __forceinline__ void rope_sc(float pos, int i, float& s, float& c) {
    float r = pos * rope_rev(i); r = r - floorf(r);
    s = __builtin_amdgcn_sinf(r); c = __builtin_amdgcn_cosf(r);
}

namespace pg8 {
constexpr int BM = 256, BK = 64, HALF = 128, HTB = HALF * BK * 2, NXCD = 8, WGM = 8;
__host__ __device__ __forceinline__ int lds_byte(int r, int c) { const int st = (r >> 4) * 2 + (c >> 5), rr = r & 15, cc = c & 31, ob = rr * 64 + cc * 2; return st * 1024 + (ob ^ (((ob >> 9) & 1) << 5)); }
__host__ __device__ __forceinline__ void stage_rc(int b, int& R, int& C) { const int st = b / 1024, sb = b % 1024, swz = sb ^ (((sb >> 9) & 1) << 5); R = (st >> 1) * 16 + swz / 64; C = (st & 1) * 32 + (swz % 64) / 2; }
__host__ __device__ __forceinline__ int perm32(int rho) { const int n = rho >> 4, i = rho & 15; return 8 * (i >> 2) + 4 * n + (i & 3); }
struct Unit { int pm, pn; };
struct Gemm { const bf16* A; const bf16* Bt; int M, N, K, lda; };
struct StaticOrder {
    int nM, nN, nwg, G, c;
    __device__ void init(int M_, int N_, int G_, int c_) { nM = M_ / BM; nN = N_ / BM; nwg = nM * nN; G = G_; c = c_; }
    __device__ bool next(int i, Unit& u) const {
        const long L = (long)i * G + c; if (L >= nwg) return false;
        int wgid = (int)L; { const int q = nwg / NXCD, r = nwg % NXCD, xcd = wgid % NXCD, off = wgid / NXCD; wgid = (xcd < r ? xcd * (q + 1) : r * (q + 1) + (xcd - r) * q) + off; }
        const int nig = WGM * nN, gid = wgid / nig, fm = gid * WGM, gsz = (nM - fm) < WGM ? (nM - fm) : WGM;
        u.pm = fm + ((wgid % nig) % gsz); u.pn = (wgid % nig) / gsz; return true;
    }
};
template <class Epi>
__device__ __forceinline__ void gemm_phase(LAS unsigned char* lds, const Gemm g, const StaticOrder& S, const Epi& E) {
    const int tid = threadIdx.x, wid = __builtin_amdgcn_readfirstlane(tid >> 6), lane = tid & 63, wr = wid >> 2, wc = wid & 3, fr = lane & 15, fq = lane >> 4;
    const int K = g.K, nt = K / BK, lda = g.lda;
    unsigned voffA[2], voffB[2];
#pragma unroll
    for (int i = 0; i < 2; ++i) { int R, C; stage_rc(tid * 16 + i * 8192, R, C); const int Rb = Epi::PERM ? ((R & ~31) + perm32(R & 31)) : R;
        voffA[i] = (unsigned)(R * lda + C) * 2u; voffB[i] = (unsigned)(Rb * K + C) * 2u; }
    const size_t kstep = (size_t)(BK * 2);
    const size_t hstepA = (size_t)HALF * lda * 2, hstepB = (size_t)HALF * K * 2;
    const size_t tstepA = 2 * hstepA, tstepB = 2 * hstepB;
    const unsigned ldsw = (unsigned)wid * 1024u;
    const int aoff = lds_byte(wr * 64 + fr, fq * 8), boff = lds_byte(wc * 32 + fr, fq * 8);
#define PG8_SA(b, h) (((b) * 2 + (h)) * HTB)
#define PG8_SB(b, h) ((4 + (b) * 2 + (h)) * HTB)
#define PG8_STAGE(bufoff, gbase, voff) do { _Pragma("unroll") for (int _i = 0; _i < 2; ++_i) \
        __builtin_amdgcn_global_load_lds((const unsigned*)((const char*)(gbase) + (voff)[_i]), (LAS unsigned*)(lds + (bufoff) + ldsw + _i * 8192), 16, 0, 0); } while (0)
#define PG8_LDA(dst, b, h) do { _Pragma("unroll") for (int m = 0; m < 4; ++m) _Pragma("unroll") for (int k = 0; k < 2; ++k) dst[m][k] = *(const LAS bf16x8*)(lds + PG8_SA(b, h) + aoff + m * 2048 + k * 1024); } while (0)
#define PG8_LDB(dst, b, h) do { _Pragma("unroll") for (int n = 0; n < 2; ++n) _Pragma("unroll") for (int k = 0; k < 2; ++k) dst[n][k] = *(const LAS bf16x8*)(lds + PG8_SB(b, h) + boff + n * 2048 + k * 1024); } while (0)
#define PG8_MMA(ai, bj, At, Bt) do { __builtin_amdgcn_s_setprio(1); _Pragma("unroll") for (int m = 0; m < 4; ++m) _Pragma("unroll") for (int n = 0; n < 2; ++n) _Pragma("unroll") for (int k = 0; k < 2; ++k) \
        acc[ai][bj][m][n] = __builtin_amdgcn_mfma_f32_16x16x32_bf16(Bt[n][k], At[m][k], acc[ai][bj][m][n], 0, 0, 0); __builtin_amdgcn_s_setprio(0); } while (0)
#define PG8_WAIT_V(n) asm volatile("s_waitcnt vmcnt(" #n ")" ::: "memory")
#define PG8_WAIT_L(n) asm volatile("s_waitcnt lgkmcnt(" #n ")" ::: "memory")
#define PG8_BAR __builtin_amdgcn_s_barrier()
#define PG8_SCHED __builtin_amdgcn_sched_barrier(0)
    Unit cur, nxt; int ui = 0;
    if (!S.next(0, cur)) return;
    f32x4 acc[2][2][4][2];
#pragma unroll
    for (int a = 0; a < 2; ++a)
#pragma unroll
        for (int b = 0; b < 2; ++b)
#pragma unroll
            for (int m = 0; m < 4; ++m)
#pragma unroll
                for (int n = 0; n < 2; ++n) acc[a][b][m][n] = (f32x4){0.f, 0.f, 0.f, 0.f};
    bf16x8 At[4][2], B0[2][2], B1[2][2];
    const char* cA = (const char*)g.A + (size_t)cur.pm * tstepA; const char* cB = (const char*)g.Bt + (size_t)cur.pn * tstepB;
    PG8_STAGE(PG8_SB(0, 0), cB, voffB); PG8_STAGE(PG8_SB(0, 1), cB + hstepB, voffB); PG8_STAGE(PG8_SA(0, 0), cA, voffA); PG8_STAGE(PG8_SA(0, 1), cA + hstepA, voffA);
    if (wr == 1) PG8_BAR;
    PG8_WAIT_V(2); PG8_BAR;
    PG8_STAGE(PG8_SB(1, 0), cB + kstep, voffB); PG8_STAGE(PG8_SA(1, 0), cA + kstep, voffA); PG8_STAGE(PG8_SB(1, 1), cB + hstepB + kstep, voffB);
    PG8_WAIT_V(6); PG8_BAR;
    for (;;) {
        const bool has_next = S.next(ui + 1, nxt);
        const char* nA = has_next ? (const char*)g.A + (size_t)nxt.pm * tstepA : cA; const char* nB = has_next ? (const char*)g.Bt + (size_t)nxt.pn * tstepB : cB;
        for (int t = 0; t < nt; t += 2) {
            const bool last = (t == nt - 2);
            const char* a1 = cA + (size_t)(t + 1) * kstep;
            const char* a2 = last ? nA : cA + (size_t)(t + 2) * kstep; const char* b2 = last ? nB : cB + (size_t)(t + 2) * kstep;
            const char* a3 = a2 + kstep; const char* b3 = b2 + kstep;
            PG8_LDB(B0, 0, 0); PG8_LDB(B1, 0, 1); PG8_SCHED; PG8_LDA(At, 0, 0); PG8_STAGE(PG8_SA(1, 1), a1 + hstepA, voffA);
            PG8_WAIT_V(8); PG8_WAIT_L(0); PG8_BAR; PG8_MMA(0, 0, At, B0); PG8_MMA(0, 1, At, B1); PG8_BAR; PG8_SCHED;
            PG8_LDA(At, 0, 1); PG8_STAGE(PG8_SB(0, 0), b2, voffB); PG8_STAGE(PG8_SB(0, 1), b2 + hstepB, voffB); PG8_STAGE(PG8_SA(0, 0), a2, voffA);
            PG8_WAIT_V(8); PG8_WAIT_L(0); PG8_BAR; PG8_MMA(1, 0, At, B0); PG8_MMA(1, 1, At, B1); PG8_BAR; PG8_SCHED;
            PG8_LDB(B0, 1, 0); PG8_LDB(B1, 1, 1); PG8_SCHED; PG8_LDA(At, 1, 0); PG8_STAGE(PG8_SA(0, 1), a2 + hstepA, voffA);
            PG8_WAIT_V(8); PG8_WAIT_L(0); PG8_BAR; PG8_MMA(0, 0, At, B0); PG8_MMA(0, 1, At, B1); PG8_BAR; PG8_SCHED;
            PG8_LDA(At, 1, 1); PG8_STAGE(PG8_SB(1, 0), b3, voffB); PG8_STAGE(PG8_SB(1, 1), b3 + hstepB, voffB); PG8_STAGE(PG8_SA(1, 0), a3, voffA);
            PG8_WAIT_V(8); PG8_WAIT_L(0); PG8_BAR; PG8_MMA(1, 0, At, B0); PG8_MMA(1, 1, At, B1); PG8_BAR; PG8_SCHED;
        }
        if (wr == 0) PG8_BAR;
        E(acc, cur, wr, wc, fr, fq, lds, wid, lane);
        if (!has_next) break;
#pragma unroll
        for (int a = 0; a < 2; ++a)
#pragma unroll
            for (int b = 0; b < 2; ++b)
#pragma unroll
                for (int m = 0; m < 4; ++m)
#pragma unroll
                    for (int n = 0; n < 2; ++n) acc[a][b][m][n] = (f32x4){0.f, 0.f, 0.f, 0.f};
        cur = nxt; cA = nA; cB = nB; ++ui;
        if (wr == 1) PG8_BAR;
    }
    PG8_WAIT_V(0);
    PG8_BAR;
#undef PG8_SA
#undef PG8_SB
#undef PG8_STAGE
#undef PG8_LDA
#undef PG8_LDB
#undef PG8_MMA
#undef PG8_WAIT_V
#undef PG8_WAIT_L
#undef PG8_BAR
#undef PG8_SCHED
}

struct EpiProj {
    static constexpr bool PERM = true;
    bf16* O; float* dt;
    __device__ __forceinline__ void operator()(f32x4 (&acc)[2][2][4][2], const Unit& u, int wr, int wc, int fr_, int fq_, LAS unsigned char* lds, int wid, int lane) const {
        int fr = fr_, fq = fq_; asm volatile("" : "+v"(fr), "+v"(fq));
        const int row0 = u.pm * BM + wr * 64 + fr;
        if (u.pn < 36) {
            const int col0 = u.pn * BM + wc * 32 + 8 * fq;
#pragma unroll
            for (int ai = 0; ai < 2; ++ai)
#pragma unroll
                for (int m = 0; m < 4; ++m) { bf16* rowp = O + (size_t)(row0 + ai * HALF + m * 16) * LDP + col0;
#pragma unroll
                    for (int bj = 0; bj < 2; ++bj) { const f32x4 v0 = acc[ai][bj][m][0], v1 = acc[ai][bj][m][1];
                        u32x4 w; w.x = pk2(v0[0], v0[1]); w.y = pk2(v0[2], v0[3]); w.z = pk2(v1[0], v1[1]); w.w = pk2(v1[2], v1[3]);
                        *(u32x4*)(rowp + bj * HALF) = w; } }
        } else if (wc == 0) {
#pragma unroll
            for (int ai = 0; ai < 2; ++ai)
#pragma unroll
                for (int m = 0; m < 4; ++m) { float* rp = dt + (size_t)(row0 + ai * HALF + m * 16) * 32 + 8 * fq;
                    *(f32x4*)rp = acc[ai][0][m][0]; *(f32x4*)(rp + 4) = acc[ai][0][m][1]; }
        }
    }
};
struct EpiRes {
    static constexpr bool PERM = true;
    const float* base; float* out; bf16* outb; float* ss;
    __device__ __forceinline__ void operator()(f32x4 (&acc)[2][2][4][2], const Unit& u, int wr, int wc, int fr_, int fq_, LAS unsigned char* lds, int wid, int lane_) const {
        int fr = fr_, fq = fq_, lane = lane_; asm volatile("" : "+v"(fr), "+v"(fq), "+v"(lane));
        LAS float* RED = (LAS float*)(lds + LDS_RED);
        const int row0 = u.pm * BM + wr * 64 + fr, col0 = u.pn * BM + wc * 32 + 8 * fq;
#pragma unroll
        for (int ai = 0; ai < 2; ++ai)
#pragma unroll
            for (int m = 0; m < 4; ++m) { const size_t off = (size_t)(row0 + ai * HALF + m * 16) * D + col0; float q = 0.f;
#pragma unroll
                for (int bj = 0; bj < 2; ++bj) {
                    const f32x4 v0 = *(const f32x4*)(base + off + bj * HALF) + acc[ai][bj][m][0], v1 = *(const f32x4*)(base + off + bj * HALF + 4) + acc[ai][bj][m][1];
                    *(f32x4*)(out + off + bj * HALF) = v0; *(f32x4*)(out + off + bj * HALF + 4) = v1;
                    if (outb) { u32x4 w; w.x = pk2(v0[0], v0[1]); w.y = pk2(v0[2], v0[3]); w.z = pk2(v1[0], v1[1]); w.w = pk2(v1[2], v1[3]); *(u32x4*)(outb + off + bj * HALF) = w; }
                    q += (v0[0] * v0[0] + v0[1] * v0[1]) + (v0[2] * v0[2] + v0[3] * v0[3]) + (v1[0] * v1[0] + v1[1] * v1[1]) + (v1[2] * v1[2] + v1[3] * v1[3]); }
                q += __shfl_xor(q, 16); q += __shfl_xor(q, 32);
                if (fq == 0) RED[(ai * HALF + wr * 64 + m * 16 + fr) * 4 + wc] = q; }
        WG_BAR();
        const int tid = wid * 64 + lane;
        if (tid < 256) { const f32x4 r = *(const LAS f32x4*)(RED + tid * 4); ss[(size_t)(u.pm * BM + tid) * 8 + u.pn] = (r[0] + r[1]) + (r[2] + r[3]); }
    }
};
struct EpiUp {
    static constexpr bool PERM = false;
    bf16* ACT; const float* SS1; const float* cw; const float* cb; float* HEADp; float* TAILp;
    __device__ __forceinline__ void operator()(f32x4 (&acc)[2][2][4][2], const Unit& u, int wr, int wc, int fr_, int fq_, LAS unsigned char* lds, int wid, int lane) const {
        int fr = fr_, fq = fq_; asm volatile("" : "+v"(fr), "+v"(fq));
        LAS float* XCH = (LAS float*)(lds + LDS_XCH);
        const int row0 = u.pm * BM + wr * 64 + fr;
#pragma unroll
        for (int ai = 0; ai < 2; ++ai)
#pragma unroll
            for (int m = 0; m < 4; ++m) { const float* sp = SS1 + (size_t)(row0 + ai * HALF + m * 16) * 8; const f32x4 a = *(const f32x4*)sp, b = *(const f32x4*)(sp + 4);
                const float rs = rsqrtf(((a[0] + a[1]) + (a[2] + a[3]) + (b[0] + b[1]) + (b[2] + b[3])) * (1.0f / D) + EPS);
#pragma unroll
                for (int bj = 0; bj < 2; ++bj)
#pragma unroll
                    for (int n = 0; n < 2; ++n) acc[ai][bj][m][n] = acc[ai][bj][m][n] * rs;
                if (m & 1) asm volatile("" ::: "memory"); }
        const int cl = wc * 32 + 4 * fq;
        if (fr >= 14) {
#pragma unroll
            for (int ai = 0; ai < 2; ++ai)
#pragma unroll
                for (int bj = 0; bj < 2; ++bj)
#pragma unroll
                    for (int n = 0; n < 2; ++n) *(LAS f32x4*)(XCH + ((2 * ai + wr) * 2 + (fr - 14)) * 256 + bj * HALF + n * 16 + cl) = acc[ai][bj][3][n];
            if (wr == 1) {
#pragma unroll
                for (int bj = 0; bj < 2; ++bj)
#pragma unroll
                    for (int n = 0; n < 2; ++n) *(f32x4*)(TAILp + (size_t)(u.pm * 2 + (fr - 14)) * NUP + u.pn * BM + bj * HALF + n * 16 + cl) = acc[1][bj][3][n];
            }
        }
        if (fr < 2 && wr == 0) {
#pragma unroll
            for (int bj = 0; bj < 2; ++bj)
#pragma unroll
                for (int n = 0; n < 2; ++n) *(f32x4*)(HEADp + (size_t)(u.pm * 2 + fr) * NUP + u.pn * BM + bj * HALF + n * 16 + cl) = acc[0][bj][0][n];
        }
        WG_BAR();
#pragma unroll
        for (int n = 0; n < 2; ++n) {
            const int ch = u.pn * HALF + n * 16 + cl;
            const f32x4 wg0 = *(const f32x4*)(cw + ch), wg1 = *(const f32x4*)(cw + NUP + ch), wg2 = *(const f32x4*)(cw + 2 * NUP + ch), bg = *(const f32x4*)(cb + ch);
            const f32x4 wv0 = *(const f32x4*)(cw + DFF + ch), wv1 = *(const f32x4*)(cw + NUP + DFF + ch), wv2 = *(const f32x4*)(cw + 2 * NUP + DFF + ch), bv = *(const f32x4*)(cb + DFF + ch);
#pragma unroll
            for (int ai = 0; ai < 2; ++ai) {
                const int pred = 2 * ai + wr - 1;
                f32x4 pg0 = (f32x4){0.f, 0.f, 0.f, 0.f}, pg1 = pg0, pv0 = pg0, pv1 = pg0;
                if (pred >= 0) { const LAS float* xp = XCH + (pred * 2) * 256 + n * 16 + cl;
                    pg0 = *(const LAS f32x4*)xp; pg1 = *(const LAS f32x4*)(xp + 256); pv0 = *(const LAS f32x4*)(xp + HALF); pv1 = *(const LAS f32x4*)(xp + 256 + HALF); }
#pragma unroll
                for (int m = 0; m < 4; ++m) {
                    const f32x4 G = acc[ai][0][m][n], V = acc[ai][1][m][n];
                    f32x4 g1, g2, v1, v2;
#pragma unroll
                    for (int j = 0; j < 4; ++j) {
                        const float a1 = ror1(G[j]), a2 = ror2(G[j]), c1 = ror1(V[j]), c2 = ror2(V[j]);
                        float h1, h2, k1, k2;
                        if (m > 0) { h1 = ror1(acc[ai][0][m > 0 ? m - 1 : 0][n][j]); h2 = ror2(acc[ai][0][m > 0 ? m - 1 : 0][n][j]); k1 = ror1(acc[ai][1][m > 0 ? m - 1 : 0][n][j]); k2 = ror2(acc[ai][1][m > 0 ? m - 1 : 0][n][j]); }
                        else { h1 = pg1[j]; h2 = (fr == 1) ? pg1[j] : pg0[j]; k1 = pv1[j]; k2 = (fr == 1) ? pv1[j] : pv0[j]; }
                        g1[j] = fr >= 1 ? a1 : h1; g2[j] = fr >= 2 ? a2 : h2; v1[j] = fr >= 1 ? c1 : k1; v2[j] = fr >= 2 ? c2 : k2;
                    }
                    const f32x4 cg_ = bg + wg0 * g2 + wg1 * g1 + wg2 * G, cv_ = bv + wv0 * v2 + wv1 * v1 + wv2 * V;
                    u32x2 w; w.x = pk2(silu(cg_[0]) * cv_[0], silu(cg_[1]) * cv_[1]); w.y = pk2(silu(cg_[2]) * cv_[2], silu(cg_[3]) * cv_[3]);
                    *(u32x2*)(ACT + (size_t)(row0 + ai * HALF + m * 16) * DFF + ch) = w;
                }
                asm volatile("" ::: "memory");
            }
        }
    }
};
}

__device__ __forceinline__ void transpose_item(const float* __restrict__ W, int ldw, int col0, bool zero, const float* __restrict__ kscale,
                                               bf16* WT, int K, int rown0, int k0, LAS float* scr, int lane) {
#pragma unroll 8
    for (int i = 0; i < 32; ++i) { const int kk = 2 * i + (lane >> 5); float v = zero ? 0.f : W[(size_t)(k0 + kk) * ldw + col0 + (lane & 31)];
        if (kscale) v *= kscale[k0 + kk]; scr[kk * 33 + (lane & 31)] = v; }
    LDS_WAIT();
    const int c = lane & 7;
#pragma unroll
    for (int j = 0; j < 4; ++j) { const int n = (lane >> 3) + 8 * j; const LAS float* s = scr + (8 * c) * 33 + n;
        u32x4 o; o.x = pk2(s[0 * 33], s[1 * 33]); o.y = pk2(s[2 * 33], s[3 * 33]); o.z = pk2(s[4 * 33], s[5 * 33]); o.w = pk2(s[6 * 33], s[7 * 33]);
        *(u32x4*)(WT + (size_t)(rown0 + n) * K + k0 + 8 * c) = o; }
    LDS_WAIT();
}

__device__ __forceinline__ void attn_item(LAS unsigned char* lds, bf16* PROJ, const float* sinks, float* ATTSS, int item, int tid, int wid, int lane) {
    const int kvh = item & 7, blk = (item >> 3) & 31, b = item >> 8;
    const int fr = lane & 15, fq = lane >> 4;
    LAS bf16* Ks = (LAS bf16*)lds;
    LAS bf16* Vs = (LAS bf16*)(lds + 36864);
    const size_t rowbase = (size_t)b * SEQ + 128 * blk;
    __syncthreads();
#pragma unroll
    for (int i = 0; i < 2; ++i) {
        const int task = tid + 512 * i, kj = task >> 2, pc = task & 3;
        u32x4 k0 = (u32x4){0u, 0u, 0u, 0u}, k1 = k0, v0 = k0, v1 = k0;
        if (blk > 0 || kj >= 128) {
            const bf16* src = PROJ + (rowbase + kj - 128) * LDP + kvh * 64 + pc * 16;
            k0 = *(const u32x4*)(src + PC_K); k1 = *(const u32x4*)(src + PC_K + 8);
            v0 = *(const u32x4*)(src + PC_V); v1 = *(const u32x4*)(src + PC_V + 8);
            if (pc == 0) {
                const float pos = (float)(128 * blk + kj - 128);
                unsigned o0[4], o1[4];
#pragma unroll
                for (int w = 0; w < 4; ++w) {
                    float s0, c0, s1, c1; rope_sc(pos, 2 * w, s0, c0); rope_sc(pos, 2 * w + 1, s1, c1);
                    const float a0 = bflo(k0[w]), a1 = bfhi(k0[w]), b0 = bflo(k1[w]), b1 = bfhi(k1[w]);
                    o0[w] = pk2(a0 * c0 - b0 * s0, a1 * c1 - b1 * s1); o1[w] = pk2(b0 * c0 + a0 * s0, b1 * c1 + a1 * s1);
                }
                k0 = (u32x4){o0[0], o0[1], o0[2], o0[3]}; k1 = (u32x4){o1[0], o1[1], o1[2], o1[3]};
            }
        }
        *(LAS u32x4*)(Ks + kj * 72 + pc * 16) = k0; *(LAS u32x4*)(Ks + kj * 72 + pc * 16 + 8) = k1;
        *(LAS u32x4*)(Vs + kj * 72 + pc * 16) = v0; *(LAS u32x4*)(Vs + kj * 72 + pc * 16 + 8) = v1;
    }
    __syncthreads();
    const int h = 4 * kvh + (wid >> 1);
    const float sink2 = sinks[h] * LOG2E;
    const float SC = 0.125f * LOG2E;
#pragma unroll 1
    for (int it = 0; it < 2; ++it) {
        const int r0 = 64 * (wid & 1) + 32 * it;
        bf16x8 qf[2][2];
#pragma unroll
        for (int jq = 0; jq < 2; ++jq) {
            const bf16* qp = PROJ + (rowbase + r0 + 16 * jq + fr) * LDP + h * 64 + 8 * fq;
            u32x4 q0 = *(const u32x4*)qp; const u32x4 q1 = *(const u32x4*)(qp + 32);
            const float pos = (float)(128 * blk + r0 + 16 * jq + fr);
            unsigned o[4];
#pragma unroll
            for (int w = 0; w < 4; ++w) {
                const float m0 = bflo(q0[w]), m1 = bfhi(q0[w]);
                const float p0 = __shfl_xor(m0, 16), p1 = __shfl_xor(m1, 16);
                float s0, c0, s1, c1; rope_sc(pos, 2 * w, s0, c0); rope_sc(pos, 2 * w + 1, s1, c1);
                const float sg = (fq == 0) ? -1.f : 1.f;
                const float r0v = (fq < 2) ? m0 * c0 + sg * p0 * s0 : m0, r1v = (fq < 2) ? m1 * c1 + sg * p1 * s1 : m1;
                o[w] = pk2(r0v, r1v);
            }
            q0 = (u32x4){o[0], o[1], o[2], o[3]};
            qf[jq][0] = __builtin_bit_cast(bf16x8, q0); qf[jq][1] = __builtin_bit_cast(bf16x8, q1);
        }
        f32x4 st[10][2];
#pragma unroll
        for (int t = 0; t < 10; ++t) { st[t][0] = (f32x4){0.f, 0.f, 0.f, 0.f}; st[t][1] = st[t][0]; }
#pragma unroll
        for (int t = 0; t < 10; ++t)
#pragma unroll
            for (int ks = 0; ks < 2; ++ks) {
                const bf16x8 a = *(const LAS bf16x8*)(Ks + (r0 + 16 * t + fr) * 72 + 32 * ks + 8 * fq);
                st[t][0] = mfma16(a, qf[0][ks], st[t][0]); st[t][1] = mfma16(a, qf[1][ks], st[t][1]);
            }
        bf16x8 pb[2][5]; float rden[2];
#pragma unroll
        for (int jq = 0; jq < 2; ++jq) {
            const int qi = r0 + 16 * jq + fr;
            float mx = sink2;
#pragma unroll
            for (int t = 0; t < 10; ++t)
#pragma unroll
                for (int r = 0; r < 4; ++r) { const int kj = r0 + 16 * t + 4 * fq + r; const bool valid = (kj > qi) && (kj <= qi + 128) && (blk > 0 || kj >= 128);
                    const float s2 = st[t][jq][r] * SC; st[t][jq][r] = valid ? s2 : -3.0e38f; mx = fmaxf(mx, st[t][jq][r]); }
            mx = fmaxf(mx, __shfl_xor(mx, 16)); mx = fmaxf(mx, __shfl_xor(mx, 32));
            float l = 0.f;
#pragma unroll
            for (int t = 0; t < 10; ++t)
#pragma unroll
                for (int r = 0; r < 4; ++r) { const float p = fexp2(st[t][jq][r] - mx); st[t][jq][r] = p; l += p; }
            l += __shfl_xor(l, 16); l += __shfl_xor(l, 32);
            rden[jq] = frcp(l + fexp2(sink2 - mx));
#pragma unroll
            for (int s = 0; s < 5; ++s) { u32x4 w; w.x = pk2(st[2 * s][jq][0], st[2 * s][jq][1]); w.y = pk2(st[2 * s][jq][2], st[2 * s][jq][3]);
                w.z = pk2(st[2 * s + 1][jq][0], st[2 * s + 1][jq][1]); w.w = pk2(st[2 * s + 1][jq][2], st[2 * s + 1][jq][3]); pb[jq][s] = __builtin_bit_cast(bf16x8, w); }
        }
        f32x4 ot[4][2];
#pragma unroll
        for (int dt = 0; dt < 4; ++dt) { ot[dt][0] = (f32x4){0.f, 0.f, 0.f, 0.f}; ot[dt][1] = ot[dt][0]; }
#pragma unroll
        for (int s = 0; s < 5; ++s)
#pragma unroll
            for (int dt = 0; dt < 4; ++dt) {
                const LAS bf16* vp = Vs + (r0 + 32 * s + 4 * fq + ((lane >> 2) & 3)) * 72 + 16 * dt + 4 * (lane & 3);
                const bf16x8 a = cat8(ldtr(vp), ldtr(vp + 16 * 72));
                ot[dt][0] = mfma16(a, pb[0][s], ot[dt][0]); ot[dt][1] = mfma16(a, pb[1][s], ot[dt][1]);
            }
#pragma unroll
        for (int jq = 0; jq < 2; ++jq) {
            const size_t row = rowbase + r0 + 16 * jq + fr; float q = 0.f;
#pragma unroll
            for (int dt = 0; dt < 4; ++dt) { const f32x4 o = ot[dt][jq] * rden[jq];
                u32x2 w; w.x = pk2(o[0], o[1]); w.y = pk2(o[2], o[3]);
                *(u32x2*)(PROJ + row * LDP + h * 64 + 16 * dt + 4 * fq) = w;
                q += (o[0] * o[0] + o[1] * o[1]) + (o[2] * o[2] + o[3] * o[3]); }
            q += __shfl_xor(q, 16); q += __shfl_xor(q, 32);
            if (fq == 0) ATTSS[row * 32 + h] = q;
        }
    }
}

__device__ __forceinline__ void ssd_state_item(LAS unsigned char* lds, const bf16* PROJ, const float* DTRAW, const float* conv_w, const float* conv_b,
                                               const float* dt_bias, const float* a_log, bf16* XCONV, float* DTV, float* ACS, bf16* STATES, int item, int tid, int wid, int lane) {
    const int g = item & 7, c = (item >> 3) & 31, b = item >> 8;
    const int fq = lane >> 4;
    const size_t rowbase = (size_t)b * SEQ + 128 * c;
    LAS bf16* XB = (LAS bf16*)lds;
    LAS float* dtl = (LAS float*)(lds + 100352);
    LAS float* acl = dtl + 512;
    __syncthreads();
    if (wid < 4) {
        const int hh = wid, h = 4 * g + hh; const float bias = dt_bias[h], a = -fexp(a_log[h]);
        const int r = 2 * lane;
        float x0 = DTRAW[(rowbase + r) * 32 + h] + bias, x1 = DTRAW[(rowbase + r + 1) * 32 + h] + bias;
        const float v0 = fmaxf(x0, 0.f) + log1pf(__expf(-fabsf(x0))), v1 = fmaxf(x1, 0.f) + log1pf(__expf(-fabsf(x1)));
        const float d0 = v0 * a, d1 = v1 * a; float s = d0 + d1;
#pragma unroll
        for (int o = 1; o < 64; o <<= 1) { const float t = __shfl_up(s, o); if (lane >= o) s += t; }
        const float cs1 = s, cs0 = s - d1;
        dtl[r * 4 + hh] = v0; dtl[(r + 1) * 4 + hh] = v1; acl[r * 4 + hh] = cs0; acl[(r + 1) * 4 + hh] = cs1;
        DTV[(rowbase + r) * 32 + h] = v0; DTV[(rowbase + r + 1) * 32 + h] = v1; ACS[(rowbase + r) * 32 + h] = cs0; ACS[(rowbase + r + 1) * 32 + h] = cs1;
    }
    __syncthreads();
    {
        const int colx = lane < 32 ? PC_X + 256 * g + 8 * lane : (lane < 48 ? PC_X + 2048 + 128 * g + 8 * (lane - 32) : PC_X + 3072 + 128 * g + 8 * (lane - 48));
        const int chx = colx - PC_X;
        float w[4][8], bia[8];
#pragma unroll
        for (int k = 0; k < 4; ++k) { const f32x4 a = *(const f32x4*)(conv_w + k * 4096 + chx), bb = *(const f32x4*)(conv_w + k * 4096 + chx + 4);
#pragma unroll
            for (int i = 0; i < 4; ++i) { w[k][i] = a[i]; w[k][4 + i] = bb[i]; } }
        { const f32x4 a = *(const f32x4*)(conv_b + chx), bb = *(const f32x4*)(conv_b + chx + 4);
#pragma unroll
            for (int i = 0; i < 4; ++i) { bia[i] = a[i]; bia[4 + i] = bb[i]; } }
        float xw[3][8];
        const int rs = 16 * wid;
#pragma unroll
        for (int k = 0; k < 3; ++k) { const int r = rs - 3 + k; u32x4 raw = (u32x4){0u, 0u, 0u, 0u};
            if (128 * c + r >= 0) raw = *(const u32x4*)(PROJ + (size_t)((long)rowbase + r) * LDP + colx);
#pragma unroll
            for (int i = 0; i < 4; ++i) { xw[k][2 * i] = bflo(raw[i]); xw[k][2 * i + 1] = bfhi(raw[i]); } }
        const int hh = (lane >> 3) & 3;
        const float alast = acl[127 * 4 + hh];
#pragma unroll 4
        for (int rr = 0; rr < 16; ++rr) {
            const int r = rs + rr;
            const u32x4 raw = *(const u32x4*)(PROJ + (rowbase + r) * LDP + colx);
            float cur[8], o[8];
#pragma unroll
            for (int i = 0; i < 4; ++i) { cur[2 * i] = bflo(raw[i]); cur[2 * i + 1] = bfhi(raw[i]); }
#pragma unroll
            for (int i = 0; i < 8; ++i) { const float v = bia[i] + w[0][i] * xw[0][i] + w[1][i] * xw[1][i] + w[2][i] * xw[2][i] + w[3][i] * cur[i]; o[i] = silu(v);
                xw[0][i] = xw[1][i]; xw[1][i] = xw[2][i]; xw[2][i] = cur[i]; }
            u32x4 wo; wo.x = pk2(o[0], o[1]); wo.y = pk2(o[2], o[3]); wo.z = pk2(o[4], o[5]); wo.w = pk2(o[6], o[7]);
            *(u32x4*)(XCONV + (rowbase + r) * 4096 + chx) = wo;
            if (lane < 48) {
                if (lane < 32) { const float sc = dtl[r * 4 + hh] * fexp(alast - acl[r * 4 + hh]);
                    wo.x = pk2(o[0] * sc, o[1] * sc); wo.y = pk2(o[2] * sc, o[3] * sc); wo.z = pk2(o[4] * sc, o[5] * sc); wo.w = pk2(o[6] * sc, o[7] * sc); }
                *(LAS u32x4*)(XB + r * 392 + 8 * lane) = wo;
            }
        }
    }
    __syncthreads();
#if defined(SSD_DBG) && SSD_DBG == 1
    return;
#endif
    {
        const int hh = wid >> 1, nh = wid & 1, h = 4 * g + hh;
        f32x4 acc[4][4];
#pragma unroll
        for (int i = 0; i < 4; ++i)
#pragma unroll
            for (int j = 0; j < 4; ++j) acc[i][j] = (f32x4){0.f, 0.f, 0.f, 0.f};
#pragma unroll
        for (int ks = 0; ks < 4; ++ks) {
            const LAS bf16* rp = XB + (32 * ks + 8 * fq + ((lane >> 2) & 3)) * 392 + 4 * (lane & 3);
            bf16x8 fa[4], fb[4];
#pragma unroll
            for (int i = 0; i < 4; ++i) { const LAS bf16* p = rp + 256 + 16 * (4 * nh + i); fa[i] = cat8(ldtr(p), ldtr(p + 4 * 392)); }
#pragma unroll
            for (int j = 0; j < 4; ++j) { const LAS bf16* p = rp + 64 * hh + 16 * j; fb[j] = cat8(ldtr(p), ldtr(p + 4 * 392)); }
#pragma unroll
            for (int i = 0; i < 4; ++i)
#pragma unroll
                for (int j = 0; j < 4; ++j) acc[i][j] = mfma16(fa[i], fb[j], acc[i][j]);
        }
        bf16* sp = STATES + ((size_t)((b * 32 + c) * 32 + h) * 64) * 128;
#pragma unroll
        for (int i = 0; i < 4; ++i)
#pragma unroll
            for (int j = 0; j < 4; ++j) { u32x2 w; w.x = pk2(acc[i][j][0], acc[i][j][1]); w.y = pk2(acc[i][j][2], acc[i][j][3]);
                *(u32x2*)(sp + (size_t)(16 * j + (lane & 15)) * 128 + 16 * (4 * nh + i) + 4 * fq) = w; }
    }
}

__device__ __forceinline__ void ssd_out_item(LAS unsigned char* lds, bf16* PROJ, const bf16* XCONV, const float* DTV, const float* ACS, const bf16* STATES,
                                             const float* ssd_d, const float* ssd_norm, int item, int tid, int wid, int lane) {
    const int g = item & 7, c = (item >> 3) & 31, b = item >> 8;
    const int fr = lane & 15, fq = lane >> 4;
    const size_t rowbase = (size_t)b * SEQ + 128 * c;
    LAS bf16* Xs = (LAS bf16*)lds;
    LAS bf16* Bs = (LAS bf16*)(lds + 67584);
    LAS bf16* Cs = (LAS bf16*)(lds + 67584 + 34816);
    LAS float* dtl = (LAS float*)(lds + 137216);
    LAS float* acl = dtl + 512;
    LAS float* ssq = acl + 512;
    __syncthreads();
#pragma unroll 4
    for (int i = 0; i < 16; ++i) {
        const int row = wid + 8 * i; const bf16* src = XCONV + (rowbase + row) * 4096;
        if (lane < 32) *(LAS u32x4*)(Xs + row * 264 + 8 * lane) = *(const u32x4*)(src + 256 * g + 8 * lane);
        else if (lane < 48) *(LAS u32x4*)(Bs + row * 136 + 8 * (lane - 32)) = *(const u32x4*)(src + 2048 + 128 * g + 8 * (lane - 32));
        else *(LAS u32x4*)(Cs + row * 136 + 8 * (lane - 48)) = *(const u32x4*)(src + 3072 + 128 * g + 8 * (lane - 48));
    }
    { const int row = tid >> 2, hh = tid & 3; dtl[hh * 128 + row] = DTV[(rowbase + row) * 32 + 4 * g + hh]; acl[hh * 128 + row] = ACS[(rowbase + row) * 32 + 4 * g + hh]; }
    __syncthreads();
#pragma unroll 1
    for (int li = 0; li < 2; ++li) {
        f32x4 Y[2][4];
        const int lt = li == 0 ? (wid >> 1) : 7 - (wid >> 1), l0 = 16 * lt, l = l0 + fr;
        bf16x8 cf[4];
#pragma unroll
        for (int kn = 0; kn < 4; ++kn) cf[kn] = *(const LAS bf16x8*)(Cs + l * 136 + 32 * kn + 8 * fq);
        float al[2];
#pragma unroll
        for (int hi = 0; hi < 2; ++hi) {
            const int hh = 2 * (wid & 1) + hi, h = 4 * g + hh;
            const bf16* pv = STATES + ((size_t)((b * 32 + c) * 32 + h) * 64) * 128;
            al[hi] = acl[hh * 128 + l]; const float el = fexp(al[hi]);
#pragma unroll
            for (int pt = 0; pt < 4; ++pt) { f32x4 yo = (f32x4){0.f, 0.f, 0.f, 0.f};
#pragma unroll
                for (int kn = 0; kn < 4; ++kn) { const bf16x8 a = __builtin_bit_cast(bf16x8, *(const u32x4*)(pv + (size_t)(16 * pt + fr) * 128 + 32 * kn + 8 * fq)); yo = mfma16(a, cf[kn], yo); }
                Y[hi][pt] = yo * el; }
            asm volatile("" ::: "memory");
        }
#pragma unroll
        for (int ss = 0; ss < 4; ++ss) {
            if (2 * ss <= lt) {
                f32x4 gq[2]; gq[0] = (f32x4){0.f, 0.f, 0.f, 0.f}; gq[1] = gq[0];
#pragma unroll
                for (int kn = 0; kn < 4; ++kn) { const bf16x8 a = *(const LAS bf16x8*)(Bs + (32 * ss + fr) * 136 + 32 * kn + 8 * fq); gq[0] = mfma16(a, cf[kn], gq[0]); }
                if (2 * ss + 1 <= lt) {
#pragma unroll
                    for (int kn = 0; kn < 4; ++kn) { const bf16x8 a = *(const LAS bf16x8*)(Bs + (32 * ss + 16 + fr) * 136 + 32 * kn + 8 * fq); gq[1] = mfma16(a, cf[kn], gq[1]); }
                }
#pragma unroll
                for (int hi = 0; hi < 2; ++hi) {
                    const int hh = 2 * (wid & 1) + hi;
                    unsigned mw[4];
#pragma unroll
                    for (int hp = 0; hp < 2; ++hp) { float v[4];
                        const f32x4 as4 = *(const LAS f32x4*)(acl + hh * 128 + 4 * fq + 32 * ss + 16 * hp), ds4 = *(const LAS f32x4*)(dtl + hh * 128 + 4 * fq + 32 * ss + 16 * hp);
#pragma unroll
                        for (int r = 0; r < 4; ++r) { const int s = 32 * ss + 16 * hp + 4 * fq + r;
                            v[r] = (s <= l) ? gq[hp][r] * fexp(al[hi] - as4[r]) * ds4[r] : 0.f; }
                        mw[2 * hp] = pk2(v[0], v[1]); mw[2 * hp + 1] = pk2(v[2], v[3]); }
                    const bf16x8 mb = __builtin_bit_cast(bf16x8, (u32x4){mw[0], mw[1], mw[2], mw[3]});
#pragma unroll
                    for (int pt = 0; pt < 4; ++pt) {
                        const LAS bf16* xp = Xs + (32 * ss + 4 * fq + ((lane >> 2) & 3)) * 264 + 64 * hh + 16 * pt + 4 * (lane & 3);
                        const bf16x8 a = cat8(ldtr(xp), ldtr(xp + 16 * 264));
                        Y[hi][pt] = mfma16(a, mb, Y[hi][pt]);
                    }
                }
            }
            asm volatile("" ::: "memory");
        }
#pragma unroll
        for (int hi = 0; hi < 2; ++hi) {
            const int hh = 2 * (wid & 1) + hi; const float dh = ssd_d[4 * g + hh];
#pragma unroll
            for (int pt = 0; pt < 4; ++pt) { const u32x2 xr = *(const LAS u32x2*)(Xs + l * 264 + 64 * hh + 16 * pt + 4 * fq);
                Y[hi][pt][0] += dh * bflo(xr.x); Y[hi][pt][1] += dh * bfhi(xr.x); Y[hi][pt][2] += dh * bflo(xr.y); Y[hi][pt][3] += dh * bfhi(xr.y); }
        }
        float q = 0.f;
#pragma unroll
        for (int hi = 0; hi < 2; ++hi) { const int hh = 2 * (wid & 1) + hi;
#pragma unroll
            for (int pt = 0; pt < 4; ++pt) { const u32x2 zr = *(const u32x2*)(PROJ + (rowbase + l) * LDP + PC_Z + 256 * g + 64 * hh + 16 * pt + 4 * fq);
                f32x4 y = Y[hi][pt]; y[0] *= silu(bflo(zr.x)); y[1] *= silu(bfhi(zr.x)); y[2] *= silu(bflo(zr.y)); y[3] *= silu(bfhi(zr.y)); Y[hi][pt] = y;
                q += (y[0] * y[0] + y[1] * y[1]) + (y[2] * y[2] + y[3] * y[3]); } }
        q += __shfl_xor(q, 16); q += __shfl_xor(q, 32);
        if (fq == 0) ssq[l * 2 + (wid & 1)] = q;
        __syncthreads();
        const float rstd = rsqrtf((ssq[l * 2] + ssq[l * 2 + 1]) * (1.0f / 256.0f) + EPS);
#pragma unroll
        for (int hi = 0; hi < 2; ++hi) { const int hh = 2 * (wid & 1) + hi;
#pragma unroll
            for (int pt = 0; pt < 4; ++pt) { const int ch = 256 * g + 64 * hh + 16 * pt + 4 * fq; const f32x4 gn = *(const f32x4*)(ssd_norm + ch); const f32x4 y = Y[hi][pt] * rstd * gn;
                u32x2 w; w.x = pk2(y[0], y[1]); w.y = pk2(y[2], y[3]);
                *(u32x2*)(PROJ + (rowbase + l) * LDP + PC_Z + ch) = w; } }
    }
}

struct Args { const float* in[18]; float* out; unsigned char* ws; int ph_lo, ph_hi; };
constexpr int NPH = 10;

__global__ void __launch_bounds__(512, 2) hymba_fwd(Args args) {
    extern __shared__ __attribute__((aligned(16))) unsigned char lds_raw[];
    LAS unsigned char* lds = (LAS unsigned char*)lds_raw;
    cg::grid_group grid = cg::this_grid();
    const int tid = threadIdx.x, lane = tid & 63, wid = __builtin_amdgcn_readfirstlane(tid >> 6);
    const int G = gridDim.x, bx = blockIdx.x;
    const int gw = bx * 8 + wid, NGW = G * 8;
    unsigned char* ws = args.ws;
    const float* x = args.in[0]; const float* norm_mix = args.in[1]; const float* w_in = args.in[2]; const float* sinks = args.in[3]; const float* attn_norm = args.in[4];
    const float* ssd_conv_w = args.in[5]; const float* ssd_conv_b = args.in[6]; const float* dt_bias = args.in[7]; const float* a_log = args.in[8]; const float* ssd_d = args.in[9];
    const float* ssd_norm = args.in[10]; const float* w_out = args.in[11]; const float* norm_ffn = args.in[12]; const float* w_up = args.in[13]; const float* ffn_conv_w = args.in[14];
    const float* ffn_conv_b = args.in[15]; const float* w_down = args.in[16]; const float* norm_final = args.in[17];
    float* out = args.out;
    bf16* XN = (bf16*)(ws + WS_XN); bf16* WIN = (bf16*)(ws + WS_WIN); bf16* WUP = (bf16*)(ws + WS_WUP); bf16* WDOWN = (bf16*)(ws + WS_WDOWN); bf16* WOUT = (bf16*)(ws + WS_WOUT);
    bf16* PROJ = (bf16*)(ws + WS_PROJ); bf16* ACT = (bf16*)(ws + WS_ACT); bf16* STATES = (bf16*)(ws + WS_STATES); bf16* H1B = (bf16*)(ws + WS_H1B); bf16* XCONV = (bf16*)(ws + WS_XCONV);
    float* DTRAW = (float*)(ws + WS_DTRAW); float* DTV = (float*)(ws + WS_DTV); float* ACS = (float*)(ws + WS_ACS); float* ATTSS = (float*)(ws + WS_ATTSS);
    float* SS1 = (float*)(ws + WS_SS1); float* SS2 = (float*)(ws + WS_SS2); float* HEADp = (float*)(ws + WS_HEAD); float* TAILp = (float*)(ws + WS_TAIL);
    const int lo = args.ph_lo, hi = args.ph_hi;
#ifndef PHMASK
#define PHMASK 0x3ff
#endif
#define IN(k) (((PHMASK >> (k)) & 1) && lo <= (k) && (k) < hi)
#define SEAM(k) do { if (IN(k) && IN((k) + 1)) { asm volatile("s_waitcnt vmcnt(0) lgkmcnt(0)" ::: "memory"); __syncthreads(); grid.sync(); \
        __builtin_amdgcn_fence(__ATOMIC_ACQUIRE, "agent"); asm volatile("s_waitcnt vmcnt(0)" ::: "memory"); __syncthreads(); } } while (0)

    if (IN(0)) {
        LAS float* scr = (LAS float*)(lds + wid * 16384);
        constexpr int I_IN = 32 * (NPROJ / 32), I_OUT = 64 * 64;
        for (int it = gw; it < I_IN + I_OUT; it += NGW) {
            if (it < I_IN) { const int kb = it / (NPROJ / 32), nb = it % (NPROJ / 32), n = 32 * nb; int oc = n; bool zero = false;
                if (n < 2048) oc = n; else if (n < 4096) oc = n + 1024; else if (n < 5120) oc = n - 2048; else if (n < 9248) oc = n; else { zero = true; oc = 0; }
                transpose_item(w_in, 9248, oc, zero, nullptr, WIN, 2048, n, 64 * kb, scr, lane); }
            else { const int r = it - I_IN, kb = r / 64, nb = r % 64; transpose_item(w_out, 2048, 32 * nb, false, nullptr, WOUT, 4096, 32 * nb, 64 * kb, scr, lane); }
        }
        for (int m = gw; m < M; m += NGW) {
            const f32x4* xr = (const f32x4*)(x + (size_t)m * D) + lane; f32x4 v[8]; float s = 0.f;
#pragma unroll
            for (int j = 0; j < 8; ++j) { v[j] = xr[64 * j]; s += (v[j][0] * v[j][0] + v[j][1] * v[j][1]) + (v[j][2] * v[j][2] + v[j][3] * v[j][3]); }
            const float rstd = rsqrtf(wave_sum(s) * (1.0f / D) + EPS);
            u32x2* o8 = (u32x2*)(XN + (size_t)m * D) + lane;
#pragma unroll
            for (int j = 0; j < 8; ++j) { const f32x4 gg = *((const f32x4*)norm_mix + lane + 64 * j); u32x2 w; w.x = pk2(v[j][0] * rstd * gg[0], v[j][1] * rstd * gg[1]); w.y = pk2(v[j][2] * rstd * gg[2], v[j][3] * rstd * gg[3]); o8[64 * j] = w; }
        }
    }
    SEAM(0);
    if (IN(1)) {
        pg8::Gemm g{XN, WIN, M, NPROJ, 2048, 2048}; pg8::StaticOrder S; S.init(M, NPROJ, G, bx);
        pg8::EpiProj E{PROJ, DTRAW};
        pg8::gemm_phase<pg8::EpiProj>(lds, g, S, E);
    }
    SEAM(1);
    if (IN(2)) {
#ifndef P2_LIMIT
#define P2_LIMIT 1024
#endif
        for (int it = bx; it < P2_LIMIT; it += G) {
            if (it < 512) attn_item(lds, PROJ, sinks, ATTSS, it, tid, wid, lane);
            else ssd_state_item(lds, PROJ, DTRAW, ssd_conv_w, ssd_conv_b, dt_bias, a_log, XCONV, DTV, ACS, STATES, it - 512, tid, wid, lane);
        }
    }
    SEAM(2);
    if (IN(3)) {
        for (int gt = bx * 512 + tid; gt < 131072; gt += G * 512) {
            const int e = gt * 4, n = e & 127, p = (e >> 7) & 63, h = (e >> 13) & 31, b = e >> 18;
            float hs[4] = {0.f, 0.f, 0.f, 0.f};
#pragma unroll 8
            for (int c = 0; c < 32; ++c) {
                u32x2* sp = (u32x2*)(STATES + ((size_t)((b * 32 + c) * 32 + h) * 64 + p) * 128 + n);
                const u32x2 sv = *sp; const float dc = fexp(ACS[((size_t)b * SEQ + 128 * c + 127) * 32 + h]);
                u32x2 w; w.x = pk2(hs[0], hs[1]); w.y = pk2(hs[2], hs[3]); *sp = w;
                hs[0] = hs[0] * dc + bflo(sv.x); hs[1] = hs[1] * dc + bfhi(sv.x); hs[2] = hs[2] * dc + bflo(sv.y); hs[3] = hs[3] * dc + bfhi(sv.y);
            }
        }
        for (int m = gw; m < M; m += NGW) {
            const float sv = lane < 32 ? ATTSS[(size_t)m * 32 + lane] : 0.f;
            const float rstd = rsqrtf(wave_sum(sv) * (1.0f / 2048.0f) + EPS);
            u32x2* o8 = (u32x2*)(PROJ + (size_t)m * LDP) + lane;
#pragma unroll
            for (int j = 0; j < 8; ++j) { const u32x2 r = o8[64 * j]; const f32x4 gg = *((const f32x4*)attn_norm + lane + 64 * j);
                u32x2 w; w.x = pk2(bflo(r.x) * rstd * gg[0], bfhi(r.x) * rstd * gg[1]); w.y = pk2(bflo(r.y) * rstd * gg[2], bfhi(r.y) * rstd * gg[3]); o8[64 * j] = w; }
        }
        LAS float* scr = (LAS float*)(lds + wid * 16384);
        constexpr int I_UP = 32 * (NUP / 32), I_DOWN = 88 * 64;
        for (int it = gw; it < I_UP + I_DOWN; it += NGW) {
            if (it < I_UP) { const int kb = it / (NUP / 32), nb = it % (NUP / 32), n = 32 * nb, pn = n >> 8, rem = n & 255, bj = rem >> 7, cc = rem & 127;
                transpose_item(w_up, NUP, bj * DFF + 128 * pn + cc, false, norm_ffn, WUP, 2048, n, 64 * kb, scr, lane); }
            else { const int r = it - I_UP, kb = r / 64, nb = r % 64; transpose_item(w_down, 2048, 32 * nb, false, nullptr, WDOWN, DFF, 32 * nb, 64 * kb, scr, lane); }
        }
    }
    SEAM(3);
    if (IN(4)) {
        for (int it = bx; it < 512; it += G) ssd_out_item(lds, PROJ, XCONV, DTV, ACS, STATES, ssd_d, ssd_norm, it, tid, wid, lane);
    }
    SEAM(4);
    if (IN(5)) {
        pg8::Gemm g{PROJ, WOUT, M, D, 4096, LDP}; pg8::StaticOrder S; S.init(M, D, G, bx);
        pg8::EpiRes E{x, out, H1B, SS1};
        pg8::gemm_phase<pg8::EpiRes>(lds, g, S, E);
    }
    SEAM(5);
    if (IN(6)) {
        pg8::Gemm g{H1B, WUP, M, NUP, 2048, 2048}; pg8::StaticOrder S; S.init(M, NUP, G, bx);
        pg8::EpiUp E{ACT, SS1, ffn_conv_w, ffn_conv_b, HEADp, TAILp};
        pg8::gemm_phase<pg8::EpiUp>(lds, g, S, E);
    }
    SEAM(6);
    if (IN(7)) {
        for (int idx = bx * 512 + tid; idx < 32 * DFF; idx += G * 512) {
            const int pm = idx / DFF, ch = idx % DFF, pn = ch >> 7, cc = ch & 127, gc = 256 * pn + cc, vc = gc + 128;
            const float* H0 = HEADp + (size_t)(pm * 2) * NUP; const float* H1 = H0 + NUP;
            float tg0 = 0.f, tg1 = 0.f, tv0 = 0.f, tv1 = 0.f;
            if ((pm & 15) != 0) { const float* T0 = TAILp + (size_t)((pm - 1) * 2) * NUP; const float* T1 = T0 + NUP; tg0 = T0[gc]; tg1 = T1[gc]; tv0 = T0[vc]; tv1 = T1[vc]; }
            const float hg0 = H0[gc], hg1 = H1[gc], hv0 = H0[vc], hv1 = H1[vc];
            const float wg0 = ffn_conv_w[ch], wg1 = ffn_conv_w[NUP + ch], wg2 = ffn_conv_w[2 * NUP + ch], bg = ffn_conv_b[ch];
            const float wv0 = ffn_conv_w[DFF + ch], wv1 = ffn_conv_w[NUP + DFF + ch], wv2 = ffn_conv_w[2 * NUP + DFF + ch], bv = ffn_conv_b[DFF + ch];
            const float g0 = bg + wg0 * tg0 + wg1 * tg1 + wg2 * hg0, v0 = bv + wv0 * tv0 + wv1 * tv1 + wv2 * hv0;
            const float g1 = bg + wg0 * tg1 + wg1 * hg0 + wg2 * hg1, v1 = bv + wv0 * tv1 + wv1 * hv0 + wv2 * hv1;
            ACT[(size_t)(256 * pm) * DFF + ch] = (bf16)f2bf(silu(g0) * v0); ACT[(size_t)(256 * pm + 1) * DFF + ch] = (bf16)f2bf(silu(g1) * v1);
        }
    }
    SEAM(7);
    if (IN(8)) {
        pg8::Gemm g{ACT, WDOWN, M, D, DFF, DFF}; pg8::StaticOrder S; S.init(M, D, G, bx);
        pg8::EpiRes E{out, out, nullptr, SS2};
        pg8::gemm_phase<pg8::EpiRes>(lds, g, S, E);
    }
    SEAM(8);
    if (IN(9)) {
        for (int m = gw; m < M; m += NGW) {
            const float sv = lane < 8 ? SS2[(size_t)m * 8 + lane] : 0.f;
            const float rstd = rsqrtf(wave_sum(sv) * (1.0f / D) + EPS);
            f32x4* o = (f32x4*)(out + (size_t)m * D) + lane;
#pragma unroll
            for (int j = 0; j < 8; ++j) { const f32x4 gg = *((const f32x4*)norm_final + lane + 64 * j); o[64 * j] = o[64 * j] * rstd * gg; }
        }
    }
#undef IN
#undef SEAM
}

#ifdef DEBUG_STOP
__device__ __forceinline__ float dbg_san(float v) { if (!(v == v) || fabsf(v) > 1e30f) return 7.0f; return fminf(fmaxf(v, -1e4f), 1e4f); }
__global__ void dbg_digest(const unsigned short* ws16, float* out, int use_out) {
    const size_t n = (size_t)(WS_END - MiB) / 2;
    for (size_t i = (size_t)blockIdx.x * blockDim.x + threadIdx.x; i < (size_t)M * D; i += (size_t)gridDim.x * blockDim.x) {
        float acc = 0.f;
        for (int k = 0; k < 11; ++k) { const size_t idx = i + (size_t)k * 16777216u; if (idx < n) acc += dbg_san(__builtin_bit_cast(float, (unsigned)ws16[idx] << 16)); }
        if (use_out) acc += dbg_san(out[i]);
        out[i] = acc;
    }
}
#endif
extern "C" void kernel_launch(void* const* d_in, const int* in_sizes, int n_in, void* d_out, int out_size, void* d_ws, size_t ws_size, hipStream_t stream) {
    static int grid = 0;
    if (grid == 0) {
        if (n_in != 18 || out_size != M * D || ws_size < WS_END) { fprintf(stderr, "kernel_launch: unexpected shapes / workspace (n_in %d out %d ws %zu)\n", n_in, out_size, ws_size); grid = -1; return; }
        int dev = 0, cus = 0, per_cu = 0;
        if (hipGetDevice(&dev) != hipSuccess || hipDeviceGetAttribute(&cus, hipDeviceAttributeMultiprocessorCount, dev) != hipSuccess) { grid = -1; return; }
        if (hipFuncSetAttribute((const void*)hymba_fwd, hipFuncAttributeMaxDynamicSharedMemorySize, LDS_BYTES) != hipSuccess) { fprintf(stderr, "kernel_launch: hipFuncSetAttribute failed\n"); grid = -1; return; }
        if (hipOccupancyMaxActiveBlocksPerMultiprocessor(&per_cu, (const void*)hymba_fwd, 512, LDS_BYTES) != hipSuccess || per_cu < 1) { fprintf(stderr, "kernel_launch: occupancy query says %d\n", per_cu); (void)hipGetLastError(); per_cu = 1; }
        grid = cus * 1;
    }
    if (grid < 0) return;
    Args a{};
    for (int i = 0; i < 18; ++i) a.in[i] = (const float*)d_in[i];
    a.out = (float*)d_out; a.ws = (unsigned char*)d_ws;
#ifndef N_LAUNCH_SPLIT
#define N_LAUNCH_SPLIT 1
#endif
#ifdef DEBUG_STOP
    for (int p = 0; p <= DEBUG_STOP; ++p) {
#else
    for (int p = 0; p < (N_LAUNCH_SPLIT > 1 ? NPH : 1); ++p) {
#endif
        a.ph_lo = (N_LAUNCH_SPLIT > 1) ? p : 0; a.ph_hi = (N_LAUNCH_SPLIT > 1) ? p + 1 : NPH;
        void* params[] = {&a};
        hipError_t e = hipLaunchCooperativeKernel((const void*)hymba_fwd, dim3(grid), dim3(512), params, LDS_BYTES, stream);
        if (e != hipSuccess) fprintf(stderr, "kernel_launch: cooperative launch failed: %s (grid %d)\n", hipGetErrorString(e), grid);
    }
#ifdef DEBUG_STOP
    dbg_digest<<<2048, 256, 0, stream>>>((const unsigned short*)((unsigned char*)d_ws + MiB), (float*)d_out, DEBUG_STOP >= 5 ? 1 : 0);
#endif
}
```

```cpp
#include <hip/hip_runtime.h>
#include <hip/hip_cooperative_groups.h>
#include <cstdio>
#include <cstdint>
namespace cg = cooperative_groups;

#define LAS __attribute__((address_space(3)))
typedef unsigned short bf16;
typedef short bf16x8 __attribute__((ext_vector_type(8)));
typedef short s16x4 __attribute__((ext_vector_type(4)));
typedef float f32x4 __attribute__((ext_vector_type(4)));
typedef unsigned u32x4 __attribute__((ext_vector_type(4)));
typedef unsigned u32x2 __attribute__((ext_vector_type(2)));

constexpr int SEQ = 4096, M = 8192, D = 2048;
constexpr int NPROJ = 9472;
constexpr int LDP = 9216;
constexpr int PC_Z = 2048, PC_K = 4096, PC_V = 4608, PC_X = 5120;
constexpr int DFF = 5632, NUP = 11264;
constexpr float EPS = 1e-6f;
constexpr float LOG2E = 1.4426950408889634f;

constexpr size_t MiB = 1u << 20;
constexpr size_t WS_XN = 1 * MiB;
constexpr size_t WS_WIN = 33 * MiB;
constexpr size_t WS_WUP = 1 * MiB, WS_WDOWN = 45 * MiB;
constexpr size_t WS_WOUT = 70 * MiB;
constexpr size_t WS_PROJ = 86 * MiB;
constexpr size_t WS_ACT = 86 * MiB;
constexpr size_t WS_STATES = 230 * MiB;
constexpr size_t WS_H1B = 230 * MiB;
constexpr size_t WS_XCONV = 262 * MiB;
constexpr size_t WS_DTRAW = 326 * MiB;
constexpr size_t WS_DTV = 327 * MiB;
constexpr size_t WS_ACS = 328 * MiB;
constexpr size_t WS_ATTSS = 329 * MiB;
constexpr size_t WS_SS1 = 330 * MiB;
constexpr size_t WS_SS2 = 330 * MiB + 512 * 1024;
constexpr size_t WS_HEAD = 331 * MiB;
constexpr size_t WS_TAIL = 334 * MiB;
constexpr size_t WS_END = 337 * MiB;

constexpr int LDS_BYTES = 147456;
constexpr int LDS_XCH = 131072;
constexpr int LDS_RED = 139264;

__device__ __forceinline__ unsigned f2bf(float f) { unsigned u = __builtin_bit_cast(unsigned, f); return (u + 0x7fffu + ((u >> 16) & 1u)) >> 16; }
typedef float f32x2_t __attribute__((ext_vector_type(2)));
typedef __bf16 bf16x2_t __attribute__((ext_vector_type(2)));
__device__ __forceinline__ unsigned pk2(float lo, float hi) { const f32x2_t v = {lo, hi}; return __builtin_bit_cast(unsigned, __builtin_convertvector(v, bf16x2_t)); }
__device__ __forceinline__ float bflo(unsigned w) { return __builtin_bit_cast(float, w << 16); }
__device__ __forceinline__ float bfhi(unsigned w) { return __builtin_bit_cast(float, w & 0xffff0000u); }
__device__ __forceinline__ float fexp2(float x) { return __builtin_amdgcn_exp2f(x); }
__device__ __forceinline__ float fexp(float x) { return __builtin_amdgcn_exp2f(x * LOG2E); }
__device__ __forceinline__ float frcp(float x) { return __builtin_amdgcn_rcpf(x); }
__device__ __forceinline__ float silu(float v) { return v * frcp(1.0f + fexp(-v)); }
__device__ __forceinline__ float wave_sum(float v) {
#pragma unroll
    for (int o = 1; o < 64; o <<= 1) v += __shfl_xor(v, o);
    return v;
}
__device__ __forceinline__ f32x4 mfma16(bf16x8 a, bf16x8 b, f32x4 c) { return __builtin_amdgcn_mfma_f32_16x16x32_bf16(a, b, c, 0, 0, 0); }
__device__ __forceinline__ s16x4 ldtr(const LAS bf16* p) { return __builtin_amdgcn_ds_read_tr16_b64_v4i16((LAS s16x4*)p); }
__device__ __forceinline__ bf16x8 cat8(s16x4 a, s16x4 b) { return __builtin_shufflevector(a, b, 0, 1, 2, 3, 4, 5, 6, 7); }
__device__ __forceinline__ float ror1(float x) { return __builtin_bit_cast(float, __builtin_amdgcn_update_dpp(0, __builtin_bit_cast(int, x), 0x121, 0xF, 0xF, false)); }
__device__ __forceinline__ float ror2(float x) { return __builtin_bit_cast(float, __builtin_amdgcn_update_dpp(0, __builtin_bit_cast(int, x), 0x122, 0xF, 0xF, false)); }
#define LDS_WAIT() asm volatile("s_waitcnt lgkmcnt(0)" ::: "memory")
#define WG_BAR() do { asm volatile("s_waitcnt lgkmcnt(0)" ::: "memory"); __builtin_amdgcn_s_barrier(); asm volatile("" ::: "memory"); } while (0)

__device__ __forceinline__ float rope_rev(int i) {
    return i == 0 ? 0.15915494309189535f : i == 1 ? 0.03086376340470123f : i == 2 ? 0.005985185712713705f : i == 3 ? 0.001160663641240061f :
           i == 4 ? 0.00022507907903927653f : i == 5 ? 4.364795279280289e-05f : i == 6 ? 8.464330808241401e-06f : 1.6414262627950345e-06f;
}
__device__ __forceinline__ void rope_sc(float pos, int i, float& s, float& c) {
    float r = pos * rope_rev(i); r = r - floorf(r);
    s = __builtin_amdgcn_sinf(r); c = __builtin_amdgcn_cosf(r);
}

namespace pg8 {
constexpr int BM = 256, BK = 64, HALF = 128, HTB = HALF * BK * 2, NXCD = 8, WGM = 8;
__host__ __device__ __forceinline__ int lds_byte(int r, int c) { const int st = (r >> 4) * 2 + (c >> 5), rr = r & 15, cc = c & 31, ob = rr * 64 + cc * 2; return st * 1024 + (ob ^ (((ob >> 9) & 1) << 5)); }
__host__ __device__ __forceinline__ void stage_rc(int b, int& R, int& C) { const int st = b / 1024, sb = b % 1024, swz = sb ^ (((sb >> 9) & 1) << 5); R = (st >> 1) * 16 + swz / 64; C = (st & 1) * 32 + (swz % 64) / 2; }
__host__ __device__ __forceinline__ int perm32(int rho) { const int n = rho >> 4, i = rho & 15; return 8 * (i >> 2) + 4 * n + (i & 3); }
struct Unit { int pm, pn; };
struct Gemm { const bf16* A; const bf16* Bt; int M, N, K, lda; };
struct StaticOrder {
    int nM, nN, nwg, G, c;
    __device__ void init(int M_, int N_, int G_, int c_) { nM = M_ / BM; nN = N_ / BM; nwg = nM * nN; G = G_; c = c_; }
    __device__ bool next(int i, Unit& u) const {
        const long L = (long)i * G + c; if (L >= nwg) return false;
        int wgid = (int)L; { const int q = nwg / NXCD, r = nwg % NXCD, xcd = wgid % NXCD, off = wgid / NXCD; wgid = (xcd < r ? xcd * (q + 1) : r * (q + 1) + (xcd - r) * q) + off; }
        const int nig = WGM * nN, gid = wgid / nig, fm = gid * WGM, gsz = (nM - fm) < WGM ? (nM - fm) : WGM;
        u.pm = fm + ((wgid % nig) % gsz); u.pn = (wgid % nig) / gsz; return true;
    }
};
template <class Epi>
__device__ __forceinline__ void gemm_phase(LAS unsigned char* lds, const Gemm g, const StaticOrder& S, const Epi& E) {
    const int tid = threadIdx.x, wid = __builtin_amdgcn_readfirstlane(tid >> 6), lane = tid & 63, wr = wid >> 2, wc = wid & 3, fr = lane & 15, fq = lane >> 4;
    const int K = g.K, nt = K / BK, lda = g.lda;
    unsigned voffA[2], voffB[2];
#pragma unroll
    for (int i = 0; i < 2; ++i) { int R, C; stage_rc(tid * 16 + i * 8192, R, C); const int Rb = Epi::PERM ? ((R & ~31) + perm32(R & 31)) : R;
        voffA[i] = (unsigned)(R * lda + C) * 2u; voffB[i] = (unsigned)(Rb * K + C) * 2u; }
    const size_t kstep = (size_t)(BK * 2);
    const size_t hstepA = (size_t)HALF * lda * 2, hstepB = (size_t)HALF * K * 2;
    const size_t tstepA = 2 * hstepA, tstepB = 2 * hstepB;
    const unsigned ldsw = (unsigned)wid * 1024u;
    const int aoff = lds_byte(wr * 64 + fr, fq * 8), boff = lds_byte(wc * 32 + fr, fq * 8);
#define PG8_SA(b, h) (((b) * 2 + (h)) * HTB)
#define PG8_SB(b, h) ((4 + (b) * 2 + (h)) * HTB)
#define PG8_STAGE(bufoff, gbase, voff) do { _Pragma("unroll") for (int _i = 0; _i < 2; ++_i) \
        __builtin_amdgcn_global_load_lds((const unsigned*)((const char*)(gbase) + (voff)[_i]), (LAS unsigned*)(lds + (bufoff) + ldsw + _i * 8192), 16, 0, 0); } while (0)
#define PG8_LDA(dst, b, h) do { _Pragma("unroll") for (int m = 0; m < 4; ++m) _Pragma("unroll") for (int k = 0; k < 2; ++k) dst[m][k] = *(const LAS bf16x8*)(lds + PG8_SA(b, h) + aoff + m * 2048 + k * 1024); } while (0)
#define PG8_LDB(dst, b, h) do { _Pragma("unroll") for (int n = 0; n < 2; ++n) _Pragma("unroll") for (int k = 0; k < 2; ++k) dst[n][k] = *(const LAS bf16x8*)(lds + PG8_SB(b, h) + boff + n * 2048 + k * 1024); } while (0)
#define PG8_MMA(ai, bj, At, Bt) do { __builtin_amdgcn_s_setprio(1); _Pragma("unroll") for (int m = 0; m < 4; ++m) _Pragma("unroll") for (int n = 0; n < 2; ++n) _Pragma("unroll") for (int k = 0; k < 2; ++k) \
        acc[ai][bj][m][n] = __builtin_amdgcn_mfma_f32_16x16x32_bf16(Bt[n][k], At[m][k], acc[ai][bj][m][n], 0, 0, 0); __builtin_amdgcn_s_setprio(0); } while (0)
#define PG8_WAIT_V(n) asm volatile("s_waitcnt vmcnt(" #n ")" ::: "memory")
#define PG8_WAIT_L(n) asm volatile("s_waitcnt lgkmcnt(" #n ")" ::: "memory")
#define PG8_BAR __builtin_amdgcn_s_barrier()
#define PG8_SCHED __builtin_amdgcn_sched_barrier(0)
    Unit cur, nxt; int ui = 0;
    if (!S.next(0, cur)) return;
    f32x4 acc[2][2][4][2];
#pragma unroll
    for (int a = 0; a < 2; ++a)
#pragma unroll
        for (int b = 0; b < 2; ++b)
#pragma unroll
            for (int m = 0; m < 4; ++m)
#pragma unroll
                for (int n = 0; n < 2; ++n) acc[a][b][m][n] = (f32x4){0.f, 0.f, 0.f, 0.f};
    bf16x8 At[4][2], B0[2][2], B1[2][2];
    const char* cA = (const char*)g.A + (size_t)cur.pm * tstepA; const char* cB = (const char*)g.Bt + (size_t)cur.pn * tstepB;
    PG8_STAGE(PG8_SB(0, 0), cB, voffB); PG8_STAGE(PG8_SB(0, 1), cB + hstepB, voffB); PG8_STAGE(PG8_SA(0, 0), cA, voffA); PG8_STAGE(PG8_SA(0, 1), cA + hstepA, voffA);
    if (wr == 1) PG8_BAR;
    PG8_WAIT_V(2); PG8_BAR;
    PG8_STAGE(PG8_SB(1, 0), cB + kstep, voffB); PG8_STAGE(PG8_SA(1, 0), cA + kstep, voffA); PG8_STAGE(PG8_SB(1, 1), cB + hstepB + kstep, voffB);
    PG8_WAIT_V(6); PG8_BAR;
    for (;;) {
        const bool has_next = S.next(ui + 1, nxt);
        const char* nA = has_next ? (const char*)g.A + (size_t)nxt.pm * tstepA : cA; const char* nB = has_next ? (const char*)g.Bt + (size_t)nxt.pn * tstepB : cB;
        for (int t = 0; t < nt; t += 2) {
            const bool last = (t == nt - 2);
            const char* a1 = cA + (size_t)(t + 1) * kstep;
            const char* a2 = last ? nA : cA + (size_t)(t + 2) * kstep; const char* b2 = last ? nB : cB + (size_t)(t + 2) * kstep;
            const char* a3 = a2 + kstep; const char* b3 = b2 + kstep;
            PG8_LDB(B0, 0, 0); PG8_LDB(B1, 0, 1); PG8_SCHED; PG8_LDA(At, 0, 0); PG8_STAGE(PG8_SA(1, 1), a1 + hstepA, voffA);
            PG8_WAIT_V(8); PG8_WAIT_L(0); PG8_BAR; PG8_MMA(0, 0, At, B0); PG8_MMA(0, 1, At, B1); PG8_BAR; PG8_SCHED;
            PG8_LDA(At, 0, 1); PG8_STAGE(PG8_SB(0, 0), b2, voffB); PG8_STAGE(PG8_SB(0, 1), b2 + hstepB, voffB); PG8_STAGE(PG8_SA(0, 0), a2, voffA);
            PG8_WAIT_V(8); PG8_WAIT_L(0); PG8_BAR; PG8_MMA(1, 0, At, B0); PG8_MMA(1, 1, At, B1); PG8_BAR; PG8_SCHED;
            PG8_LDB(B0, 1, 0); PG8_LDB(B1, 1, 1); PG8_SCHED; PG8_LDA(At, 1, 0); PG8_STAGE(PG8_SA(0, 1), a2 + hstepA, voffA);
            PG8_WAIT_V(8); PG8_WAIT_L(0); PG8_BAR; PG8_MMA(0, 0, At, B0); PG8_MMA(0, 1, At, B1); PG8_BAR; PG8_SCHED;
            PG8_LDA(At, 1, 1); PG8_STAGE(PG8_SB(1, 0), b3, voffB); PG8_STAGE(PG8_SB(1, 1), b3 + hstepB, voffB); PG8_STAGE(PG8_SA(1, 0), a3, voffA);
            PG8_WAIT_V(8); PG8_WAIT_L(0); PG8_BAR; PG8_MMA(1, 0, At, B0); PG8_MMA(1, 1, At, B1); PG8_BAR; PG8_SCHED;
        }
        if (wr == 0) PG8_BAR;
        E(acc, cur, wr, wc, fr, fq, lds, wid, lane);
        if (!has_next) break;
#pragma unroll
        for (int a = 0; a < 2; ++a)
#pragma unroll
            for (int b = 0; b < 2; ++b)
#pragma unroll
                for (int m = 0; m < 4; ++m)
#pragma unroll
                    for (int n = 0; n < 2; ++n) acc[a][b][m][n] = (f32x4){0.f, 0.f, 0.f, 0.f};
        cur = nxt; cA = nA; cB = nB; ++ui;
        if (wr == 1) PG8_BAR;
    }
    PG8_WAIT_V(0);
    PG8_BAR;
#undef PG8_SA
#undef PG8_SB
#undef PG8_STAGE
#undef PG8_LDA
#undef PG8_LDB
#undef PG8_MMA
#undef PG8_WAIT_V
#undef PG8_WAIT_L
#undef PG8_BAR
#undef PG8_SCHED
}

struct EpiProj {
    static constexpr bool PERM = true;
    bf16* O; float* dt;
    __device__ __forceinline__ void operator()(f32x4 (&acc)[2][2][4][2], const Unit& u, int wr, int wc, int fr_, int fq_, LAS unsigned char* lds, int wid, int lane) const {
        int fr = fr_, fq = fq_; asm volatile("" : "+v"(fr), "+v"(fq));
        const int row0 = u.pm * BM + wr * 64 + fr;
        if (u.pn < 36) {
            const int col0 = u.pn * BM + wc * 32 + 8 * fq;
#pragma unroll
            for (int ai = 0; ai < 2; ++ai)
#pragma unroll
                for (int m = 0; m < 4; ++m) { bf16* rowp = O + (size_t)(row0 + ai * HALF + m * 16) * LDP + col0;
#pragma unroll
                    for (int bj = 0; bj < 2; ++bj) { const f32x4 v0 = acc[ai][bj][m][0], v1 = acc[ai][bj][m][1];
                        u32x4 w; w.x = pk2(v0[0], v0[1]); w.y = pk2(v0[2], v0[3]); w.z = pk2(v1[0], v1[1]); w.w = pk2(v1[2], v1[3]);
                        *(u32x4*)(rowp + bj * HALF) = w; } }
        } else if (wc == 0) {
#pragma unroll
            for (int ai = 0; ai < 2; ++ai)
#pragma unroll
                for (int m = 0; m < 4; ++m) { float* rp = dt + (size_t)(row0 + ai * HALF + m * 16) * 32 + 8 * fq;
                    *(f32x4*)rp = acc[ai][0][m][0]; *(f32x4*)(rp + 4) = acc[ai][0][m][1]; }
        }
    }
};
struct EpiRes {
    static constexpr bool PERM = true;
    const float* base; float* out; bf16* outb; float* ss;
    __device__ __forceinline__ void operator()(f32x4 (&acc)[2][2][4][2], const Unit& u, int wr, int wc, int fr_, int fq_, LAS unsigned char* lds, int wid, int lane_) const {
        int fr = fr_, fq = fq_, lane = lane_; asm volatile("" : "+v"(fr), "+v"(fq), "+v"(lane));
        LAS float* RED = (LAS float*)(lds + LDS_RED);
        const int row0 = u.pm * BM + wr * 64 + fr, col0 = u.pn * BM + wc * 32 + 8 * fq;
#pragma unroll
        for (int ai = 0; ai < 2; ++ai)
#pragma unroll
            for (int m = 0; m < 4; ++m) { const size_t off = (size_t)(row0 + ai * HALF + m * 16) * D + col0; float q = 0.f;
#pragma unroll
                for (int bj = 0; bj < 2; ++bj) {
                    const f32x4 v0 = *(const f32x4*)(base + off + bj * HALF) + acc[ai][bj][m][0], v1 = *(const f32x4*)(base + off + bj * HALF + 4) + acc[ai][bj][m][1];
                    *(f32x4*)(out + off + bj * HALF) = v0; *(f32x4*)(out + off + bj * HALF + 4) = v1;
                    if (outb) { u32x4 w; w.x = pk2(v0[0], v0[1]); w.y = pk2(v0[2], v0[3]); w.z = pk2(v1[0], v1[1]); w.w = pk2(v1[2], v1[3]); *(u32x4*)(outb + off + bj * HALF) = w; }
                    q += (v0[0] * v0[0] + v0[1] * v0[1]) + (v0[2] * v0[2] + v0[3] * v0[3]) + (v1[0] * v1[0] + v1[1] * v1[1]) + (v1[2] * v1[2] + v1[3] * v1[3]); }
                q += __shfl_xor(q, 16); q += __shfl_xor(q, 32);
                if (fq == 0) RED[(ai * HALF + wr * 64 + m * 16 + fr) * 4 + wc] = q; }
        WG_BAR();
        const int tid = wid * 64 + lane;
        if (tid < 256) { const f32x4 r = *(const LAS f32x4*)(RED + tid * 4); ss[(size_t)(u.pm * BM + tid) * 8 + u.pn] = (r[0] + r[1]) + (r[2] + r[3]); }
    }
};
struct EpiUp {
    static constexpr bool PERM = false;
    bf16* ACT; const float* SS1; const float* cw; const float* cb; float* HEADp; float* TAILp;
    __device__ __forceinline__ void operator()(f32x4 (&acc)[2][2][4][2], const Unit& u, int wr, int wc, int fr_, int fq_, LAS unsigned char* lds, int wid, int lane) const {
        int fr = fr_, fq = fq_; asm volatile("" : "+v"(fr), "+v"(fq));
        LAS float* XCH = (LAS float*)(lds + LDS_XCH);
        const int row0 = u.pm * BM + wr * 64 + fr;
#pragma unroll
        for (int ai = 0; ai < 2; ++ai)
#pragma unroll
            for (int m = 0; m < 4; ++m) { const float* sp = SS1 + (size_t)(row0 + ai * HALF + m * 16) * 8; const f32x4 a = *(const f32x4*)sp, b = *(const f32x4*)(sp + 4);
                const float rs = rsqrtf(((a[0] + a[1]) + (a[2] + a[3]) + (b[0] + b[1]) + (b[2] + b[3])) * (1.0f / D) + EPS);
#pragma unroll
                for (int bj = 0; bj < 2; ++bj)
#pragma unroll
                    for (int n = 0; n < 2; ++n) acc[ai][bj][m][n] = acc[ai][bj][m][n] * rs;
                if (m & 1) asm volatile("" ::: "memory"); }
        const int cl = wc * 32 + 4 * fq;
        if (fr >= 14) {
#pragma unroll
            for (int ai = 0; ai < 2; ++ai)
#pragma unroll
                for (int bj = 0; bj < 2; ++bj)
#pragma unroll
                    for (int n = 0; n < 2; ++n) *(LAS f32x4*)(XCH + ((2 * ai + wr) * 2 + (fr - 14)) * 256 + bj * HALF + n * 16 + cl) = acc[ai][bj][3][n];
            if (wr == 1) {
#pragma unroll
                for (int bj = 0; bj < 2; ++bj)
#pragma unroll
                    for (int n = 0; n < 2; ++n) *(f32x4*)(TAILp + (size_t)(u.pm * 2 + (fr - 14)) * NUP + u.pn * BM + bj * HALF + n * 16 + cl) = acc[1][bj][3][n];
            }
        }
        if (fr < 2 && wr == 0) {
#pragma unroll
            for (int bj = 0; bj < 2; ++bj)
#pragma unroll
                for (int n = 0; n < 2; ++n) *(f32x4*)(HEADp + (size_t)(u.pm * 2 + fr) * NUP + u.pn * BM + bj * HALF + n * 16 + cl) = acc[0][bj][0][n];
        }
        WG_BAR();
#pragma unroll
        for (int n = 0; n < 2; ++n) {
            const int ch = u.pn * HALF + n * 16 + cl;
            const f32x4 wg0 = *(const f32x4*)(cw + ch), wg1 = *(const f32x4*)(cw + NUP + ch), wg2 = *(const f32x4*)(cw + 2 * NUP + ch), bg = *(const f32x4*)(cb + ch);
            const f32x4 wv0 = *(const f32x4*)(cw + DFF + ch), wv1 = *(const f32x4*)(cw + NUP + DFF + ch), wv2 = *(const f32x4*)(cw + 2 * NUP + DFF + ch), bv = *(const f32x4*)(cb + DFF + ch);
#pragma unroll
            for (int ai = 0; ai < 2; ++ai) {
                const int pred = 2 * ai + wr - 1;
                f32x4 pg0 = (f32x4){0.f, 0.f, 0.f, 0.f}, pg1 = pg0, pv0 = pg0, pv1 = pg0;
                if (pred >= 0) { const LAS float* xp = XCH + (pred * 2) * 256 + n * 16 + cl;
                    pg0 = *(const LAS f32x4*)xp; pg1 = *(const LAS f32x4*)(xp + 256); pv0 = *(const LAS f32x4*)(xp + HALF); pv1 = *(const LAS f32x4*)(xp + 256 + HALF); }
#pragma unroll
                for (int m = 0; m < 4; ++m) {
                    const f32x4 G = acc[ai][0][m][n], V = acc[ai][1][m][n];
                    f32x4 g1, g2, v1, v2;
#pragma unroll
                    for (int j = 0; j < 4; ++j) {
                        const float a1 = ror1(G[j]), a2 = ror2(G[j]), c1 = ror1(V[j]), c2 = ror2(V[j]);
                        float h1, h2, k1, k2;
                        if (m > 0) { h1 = ror1(acc[ai][0][m > 0 ? m - 1 : 0][n][j]); h2 = ror2(acc[ai][0][m > 0 ? m - 1 : 0][n][j]); k1 = ror1(acc[ai][1][m > 0 ? m - 1 : 0][n][j]); k2 = ror2(acc[ai][1][m > 0 ? m - 1 : 0][n][j]); }
                        else { h1 = pg1[j]; h2 = (fr == 1) ? pg1[j] : pg0[j]; k1 = pv1[j]; k2 = (fr == 1) ? pv1[j] : pv0[j]; }
                        g1[j] = fr >= 1 ? a1 : h1; g2[j] = fr >= 2 ? a2 : h2; v1[j] = fr >= 1 ? c1 : k1; v2[j] = fr >= 2 ? c2 : k2;
                    }
                    const f32x4 cg_ = bg + wg0 * g2 + wg1 * g1 + wg2 * G, cv_ = bv + wv0 * v2 + wv1 * v1 + wv2 * V;
                    u32x2 w; w.x = pk2(silu(cg_[0]) * cv_[0], silu(cg_[1]) * cv_[1]); w.y = pk2(silu(cg_[2]) * cv_[2], silu(cg_[3]) * cv_[3]);
                    *(u32x2*)(ACT + (size_t)(row0 + ai * HALF + m * 16) * DFF + ch) = w;
                }
                asm volatile("" ::: "memory");
            }
        }
    }
};
}

__device__ __forceinline__ void transpose_item(const float* __restrict__ W, int ldw, int col0, bool zero, const float* __restrict__ kscale,
                                               bf16* WT, int K, int rown0, int k0, LAS float* scr, int lane) {
#pragma unroll 8
    for (int i = 0; i < 32; ++i) { const int kk = 2 * i + (lane >> 5); float v = zero ? 0.f : W[(size_t)(k0 + kk) * ldw + col0 + (lane & 31)];
        if (kscale) v *= kscale[k0 + kk]; scr[kk * 33 + (lane & 31)] = v; }
    LDS_WAIT();
    const int c = lane & 7;
#pragma unroll
    for (int j = 0; j < 4; ++j) { const int n = (lane >> 3) + 8 * j; const LAS float* s = scr + (8 * c) * 33 + n;
        u32x4 o; o.x = pk2(s[0 * 33], s[1 * 33]); o.y = pk2(s[2 * 33], s[3 * 33]); o.z = pk2(s[4 * 33], s[5 * 33]); o.w = pk2(s[6 * 33], s[7 * 33]);
        *(u32x4*)(WT + (size_t)(rown0 + n) * K + k0 + 8 * c) = o; }
    LDS_WAIT();
}

__device__ __forceinline__ void attn_item(LAS unsigned char* lds, bf16* PROJ, const float* sinks, float* ATTSS, int item, int tid, int wid, int lane) {
    const int kvh = item & 7, blk = (item >> 3) & 31, b = item >> 8;
    const int fr = lane & 15, fq = lane >> 4;
    LAS bf16* Ks = (LAS bf16*)lds;
    LAS bf16* Vs = (LAS bf16*)(lds + 36864);
    const size_t rowbase = (size_t)b * SEQ + 128 * blk;
    __syncthreads();
#pragma unroll
    for (int i = 0; i < 2; ++i) {
        const int task = tid + 512 * i, kj = task >> 2, pc = task & 3;
        u32x4 k0 = (u32x4){0u, 0u, 0u, 0u}, k1 = k0, v0 = k0, v1 = k0;
        if (blk > 0 || kj >= 128) {
            const bf16* src = PROJ + (rowbase + kj - 128) * LDP + kvh * 64 + pc * 16;
            k0 = *(const u32x4*)(src + PC_K); k1 = *(const u32x4*)(src + PC_K + 8);
            v0 = *(const u32x4*)(src + PC_V); v1 = *(const u32x4*)(src + PC_V + 8);
            if (pc == 0) {
                const float pos = (float)(128 * blk + kj - 128);
                unsigned o0[4], o1[4];
#pragma unroll
                for (int w = 0; w < 4; ++w) {
                    float s0, c0, s1, c1; rope_sc(pos, 2 * w, s0, c0); rope_sc(pos, 2 * w + 1, s1, c1);
                    const float a0 = bflo(k0[w]), a1 = bfhi(k0[w]), b0 = bflo(k1[w]), b1 = bfhi(k1[w]);
                    o0[w] = pk2(a0 * c0 - b0 * s0, a1 * c1 - b1 * s1); o1[w] = pk2(b0 * c0 + a0 * s0, b1 * c1 + a1 * s1);
                }
                k0 = (u32x4){o0[0], o0[1], o0[2], o0[3]}; k1 = (u32x4){o1[0], o1[1], o1[2], o1[3]};
            }
        }
        *(LAS u32x4*)(Ks + kj * 72 + pc * 16) = k0; *(LAS u32x4*)(Ks + kj * 72 + pc * 16 + 8) = k1;
        *(LAS u32x4*)(Vs + kj * 72 + pc * 16) = v0; *(LAS u32x4*)(Vs + kj * 72 + pc * 16 + 8) = v1;
    }
    __syncthreads();
    const int h = 4 * kvh + (wid >> 1);
    const float sink2 = sinks[h] * LOG2E;
    const float SC = 0.125f * LOG2E;
#pragma unroll 1
    for (int it = 0; it < 2; ++it) {
        const int r0 = 64 * (wid & 1) + 32 * it;
        bf16x8 qf[2][2];
#pragma unroll
        for (int jq = 0; jq < 2; ++jq) {
            const bf16* qp = PROJ + (rowbase + r0 + 16 * jq + fr) * LDP + h * 64 + 8 * fq;
            u32x4 q0 = *(const u32x4*)qp; const u32x4 q1 = *(const u32x4*)(qp + 32);
            const float pos = (float)(128 * blk + r0 + 16 * jq + fr);
            unsigned o[4];
#pragma unroll
            for (int w = 0; w < 4; ++w) {
                const float m0 = bflo(q0[w]), m1 = bfhi(q0[w]);
                const float p0 = __shfl_xor(m0, 16), p1 = __shfl_xor(m1, 16);
                float s0, c0, s1, c1; rope_sc(pos, 2 * w, s0, c0); rope_sc(pos, 2 * w + 1, s1, c1);
                const float sg = (fq == 0) ? -1.f : 1.f;
                const float r0v = (fq < 2) ? m0 * c0 + sg * p0 * s0 : m0, r1v = (fq < 2) ? m1 * c1 + sg * p1 * s1 : m1;
                o[w] = pk2(r0v, r1v);
            }
            q0 = (u32x4){o[0], o[1], o[2], o[3]};
            qf[jq][0] = __builtin_bit_cast(bf16x8, q0); qf[jq][1] = __builtin_bit_cast(bf16x8, q1);
        }
        f32x4 st[10][2];
#pragma unroll
        for (int t = 0; t < 10; ++t) { st[t][0] = (f32x4){0.f, 0.f, 0.f, 0.f}; st[t][1] = st[t][0]; }
#pragma unroll
        for (int t = 0; t < 10; ++t)
#pragma unroll
            for (int ks = 0; ks < 2; ++ks) {
                const bf16x8 a = *(const LAS bf16x8*)(Ks + (r0 + 16 * t + fr) * 72 + 32 * ks + 8 * fq);
                st[t][0] = mfma16(a, qf[0][ks], st[t][0]); st[t][1] = mfma16(a, qf[1][ks], st[t][1]);
            }
        bf16x8 pb[2][5]; float rden[2];
#pragma unroll
        for (int jq = 0; jq < 2; ++jq) {
            const int qi = r0 + 16 * jq + fr;
            float mx = sink2;
#pragma unroll
            for (int t = 0; t < 10; ++t)
#pragma unroll
                for (int r = 0; r < 4; ++r) { const int kj = r0 + 16 * t + 4 * fq + r; const bool valid = (kj > qi) && (kj <= qi + 128) && (blk > 0 || kj >= 128);
                    const float s2 = st[t][jq][r] * SC; st[t][jq][r] = valid ? s2 : -3.0e38f; mx = fmaxf(mx, st[t][jq][r]); }
            mx = fmaxf(mx, __shfl_xor(mx, 16)); mx = fmaxf(mx, __shfl_xor(mx, 32));
            float l = 0.f;
#pragma unroll
            for (int t = 0; t < 10; ++t)
#pragma unroll
                for (int r = 0; r < 4; ++r) { const float p = fexp2(st[t][jq][r] - mx); st[t][jq][r] = p; l += p; }
            l += __shfl_xor(l, 16); l += __shfl_xor(l, 32);
            rden[jq] = frcp(l + fexp2(sink2 - mx));
#pragma unroll
            for (int s = 0; s < 5; ++s) { u32x4 w; w.x = pk2(st[2 * s][jq][0], st[2 * s][jq][1]); w.y = pk2(st[2 * s][jq][2], st[2 * s][jq][3]);
                w.z = pk2(st[2 * s + 1][jq][0], st[2 * s + 1][jq][1]); w.w = pk2(st[2 * s + 1][jq][2], st[2 * s + 1][jq][3]); pb[jq][s] = __builtin_bit_cast(bf16x8, w); }
        }
        f32x4 ot[4][2];
#pragma unroll
        for (int dt = 0; dt < 4; ++dt) { ot[dt][0] = (f32x4){0.f, 0.f, 0.f, 0.f}; ot[dt][1] = ot[dt][0]; }
#pragma unroll
        for (int s = 0; s < 5; ++s)
#pragma unroll
            for (int dt = 0; dt < 4; ++dt) {
                const LAS bf16* vp = Vs + (r0 + 32 * s + 4 * fq + ((lane >> 2) & 3)) * 72 + 16 * dt + 4 * (lane & 3);
                const bf16x8 a = cat8(ldtr(vp), ldtr(vp + 16 * 72));
                ot[dt][0] = mfma16(a, pb[0][s], ot[dt][0]); ot[dt][1] = mfma16(a, pb[1][s], ot[dt][1]);
            }
#pragma unroll
        for (int jq = 0; jq < 2; ++jq) {
            const size_t row = rowbase + r0 + 16 * jq + fr; float q = 0.f;
#pragma unroll
            for (int dt = 0; dt < 4; ++dt) { const f32x4 o = ot[dt][jq] * rden[jq];
                u32x2 w; w.x = pk2(o[0], o[1]); w.y = pk2(o[2], o[3]);
                *(u32x2*)(PROJ + row * LDP + h * 64 + 16 * dt + 4 * fq) = w;
                q += (o[0] * o[0] + o[1] * o[1]) + (o[2] * o[2] + o[3] * o[3]); }
            q += __shfl_xor(q, 16); q += __shfl_xor(q, 32);
            if (fq == 0) ATTSS[row * 32 + h] = q;
        }
    }
}

__device__ __forceinline__ void ssd_state_item(LAS unsigned char* lds, const bf16* PROJ, const float* DTRAW, const float* conv_w, const float* conv_b,
                                               const float* dt_bias, const float* a_log, bf16* XCONV, float* DTV, float* ACS, bf16* STATES, int item, int tid, int wid, int lane) {
    const int g = item & 7, c = (item >> 3) & 31, b = item >> 8;
    const int fq = lane >> 4;
    const size_t rowbase = (size_t)b * SEQ + 128 * c;
    LAS bf16* XB = (LAS bf16*)lds;
    LAS float* dtl = (LAS float*)(lds + 100352);
    LAS float* acl = dtl + 512;
    __syncthreads();
    if (wid < 4) {
        const int hh = wid, h = 4 * g + hh; const float bias = dt_bias[h], a = -fexp(a_log[h]);
        const int r = 2 * lane;
        float x0 = DTRAW[(rowbase + r) * 32 + h] + bias, x1 = DTRAW[(rowbase + r + 1) * 32 + h] + bias;
        const float v0 = fmaxf(x0, 0.f) + log1pf(__expf(-fabsf(x0))), v1 = fmaxf(x1, 0.f) + log1pf(__expf(-fabsf(x1)));
        const float d0 = v0 * a, d1 = v1 * a; float s = d0 + d1;
#pragma unroll
        for (int o = 1; o < 64; o <<= 1) { const float t = __shfl_up(s, o); if (lane >= o) s += t; }
        const float cs1 = s, cs0 = s - d1;
        dtl[r * 4 + hh] = v0; dtl[(r + 1) * 4 + hh] = v1; acl[r * 4 + hh] = cs0; acl[(r + 1) * 4 + hh] = cs1;
        DTV[(rowbase + r) * 32 + h] = v0; DTV[(rowbase + r + 1) * 32 + h] = v1; ACS[(rowbase + r) * 32 + h] = cs0; ACS[(rowbase + r + 1) * 32 + h] = cs1;
    }
    __syncthreads();
    {
        const int colx = lane < 32 ? PC_X + 256 * g + 8 * lane : (lane < 48 ? PC_X + 2048 + 128 * g + 8 * (lane - 32) : PC_X + 3072 + 128 * g + 8 * (lane - 48));
        const int chx = colx - PC_X;
        float w[4][8], bia[8];
#pragma unroll
        for (int k = 0; k < 4; ++k) { const f32x4 a = *(const f32x4*)(conv_w + k * 4096 + chx), bb = *(const f32x4*)(conv_w + k * 4096 + chx + 4);
#pragma unroll
            for (int i = 0; i < 4; ++i) { w[k][i] = a[i]; w[k][4 + i] = bb[i]; } }
        { const f32x4 a = *(const f32x4*)(conv_b + chx), bb = *(const f32x4*)(conv_b + chx + 4);
#pragma unroll
            for (int i = 0; i < 4; ++i) { bia[i] = a[i]; bia[4 + i] = bb[i]; } }
        float xw[3][8];
        const int rs = 16 * wid;
#pragma unroll
        for (int k = 0; k < 3; ++k) { const int r = rs - 3 + k; u32x4 raw = (u32x4){0u, 0u, 0u, 0u};
            if (128 * c + r >= 0) raw = *(const u32x4*)(PROJ + (size_t)((long)rowbase + r) * LDP + colx);
#pragma unroll
            for (int i = 0; i < 4; ++i) { xw[k][2 * i] = bflo(raw[i]); xw[k][2 * i + 1] = bfhi(raw[i]); } }
        const int hh = (lane >> 3) & 3;
        const float alast = acl[127 * 4 + hh];
#pragma unroll 4
        for (int rr = 0; rr < 16; ++rr) {
            const int r = rs + rr;
            const u32x4 raw = *(const u32x4*)(PROJ + (rowbase + r) * LDP + colx);
            float cur[8], o[8];
#pragma unroll
            for (int i = 0; i < 4; ++i) { cur[2 * i] = bflo(raw[i]); cur[2 * i + 1] = bfhi(raw[i]); }
#pragma unroll
            for (int i = 0; i < 8; ++i) { const float v = bia[i] + w[0][i] * xw[0][i] + w[1][i] * xw[1][i] + w[2][i] * xw[2][i] + w[3][i] * cur[i]; o[i] = silu(v);
                xw[0][i] = xw[1][i]; xw[1][i] = xw[2][i]; xw[2][i] = cur[i]; }
            u32x4 wo; wo.x = pk2(o[0], o[1]); wo.y = pk2(o[2], o[3]); wo.z = pk2(o[4], o[5]); wo.w = pk2(o[6], o[7]);
            *(u32x4*)(XCONV + (rowbase + r) * 4096 + chx) = wo;
            if (lane < 48) {
                if (lane < 32) { const float sc = dtl[r * 4 + hh] * fexp(alast - acl[r * 4 + hh]);
                    wo.x = pk2(o[0] * sc, o[1] * sc); wo.y = pk2(o[2] * sc, o[3] * sc); wo.z = pk2(o[4] * sc, o[5] * sc); wo.w = pk2(o[6] * sc, o[7] * sc); }
                *(LAS u32x4*)(XB + r * 392 + 8 * lane) = wo;
            }
        }
    }
    __syncthreads();
#if defined(SSD_DBG) && SSD_DBG == 1
    return;
#endif
    {
        const int hh = wid >> 1, nh = wid & 1, h = 4 * g + hh;
        f32x4 acc[4][4];
#pragma unroll
        for (int i = 0; i < 4; ++i)
#pragma unroll
            for (int j = 0; j < 4; ++j) acc[i][j] = (f32x4){0.f, 0.f, 0.f, 0.f};
#pragma unroll
        for (int ks = 0; ks < 4; ++ks) {
            const LAS bf16* rp = XB + (32 * ks + 8 * fq + ((lane >> 2) & 3)) * 392 + 4 * (lane & 3);
            bf16x8 fa[4], fb[4];
#pragma unroll
            for (int i = 0; i < 4; ++i) { const LAS bf16* p = rp + 256 + 16 * (4 * nh + i); fa[i] = cat8(ldtr(p), ldtr(p + 4 * 392)); }
#pragma unroll
            for (int j = 0; j < 4; ++j) { const LAS bf16* p = rp + 64 * hh + 16 * j; fb[j] = cat8(ldtr(p), ldtr(p + 4 * 392)); }
#pragma unroll
            for (int i = 0; i < 4; ++i)
#pragma unroll
                for (int j = 0; j < 4; ++j) acc[i][j] = mfma16(fa[i], fb[j], acc[i][j]);
        }
        bf16* sp = STATES + ((size_t)((b * 32 + c) * 32 + h) * 64) * 128;
#pragma unroll
        for (int i = 0; i < 4; ++i)
#pragma unroll
            for (int j = 0; j < 4; ++j) { u32x2 w; w.x = pk2(acc[i][j][0], acc[i][j][1]); w.y = pk2(acc[i][j][2], acc[i][j][3]);
                *(u32x2*)(sp + (size_t)(16 * j + (lane & 15)) * 128 + 16 * (4 * nh + i) + 4 * fq) = w; }
    }
}

__device__ __forceinline__ void ssd_out_item(LAS unsigned char* lds, bf16* PROJ, const bf16* XCONV, const float* DTV, const float* ACS, const bf16* STATES,
                                             const float* ssd_d, const float* ssd_norm, int item, int tid, int wid, int lane) {
    const int g = item & 7, c = (item >> 3) & 31, b = item >> 8;
    const int fr = lane & 15, fq = lane >> 4;
    const size_t rowbase = (size_t)b * SEQ + 128 * c;
    LAS bf16* Xs = (LAS bf16*)lds;
    LAS bf16* Bs = (LAS bf16*)(lds + 67584);
    LAS bf16* Cs = (LAS bf16*)(lds + 67584 + 34816);
    LAS float* dtl = (LAS float*)(lds + 137216);
    LAS float* acl = dtl + 512;
    LAS float* ssq = acl + 512;
    __syncthreads();
#pragma unroll 4
    for (int i = 0; i < 16; ++i) {
        const int row = wid + 8 * i; const bf16* src = XCONV + (rowbase + row) * 4096;
        if (lane < 32) *(LAS u32x4*)(Xs + row * 264 + 8 * lane) = *(const u32x4*)(src + 256 * g + 8 * lane);
        else if (lane < 48) *(LAS u32x4*)(Bs + row * 136 + 8 * (lane - 32)) = *(const u32x4*)(src + 2048 + 128 * g + 8 * (lane - 32));
        else *(LAS u32x4*)(Cs + row * 136 + 8 * (lane - 48)) = *(const u32x4*)(src + 3072 + 128 * g + 8 * (lane - 48));
    }
    { const int row = tid >> 2, hh = tid & 3; dtl[hh * 128 + row] = DTV[(rowbase + row) * 32 + 4 * g + hh]; acl[hh * 128 + row] = ACS[(rowbase + row) * 32 + 4 * g + hh]; }
    __syncthreads();
#pragma unroll 1
    for (int li = 0; li < 2; ++li) {
        f32x4 Y[2][4];
        const int lt = li == 0 ? (wid >> 1) : 7 - (wid >> 1), l0 = 16 * lt, l = l0 + fr;
        bf16x8 cf[4];
#pragma unroll
        for (int kn = 0; kn < 4; ++kn) cf[kn] = *(const LAS bf16x8*)(Cs + l * 136 + 32 * kn + 8 * fq);
        float al[2];
#pragma unroll
        for (int hi = 0; hi < 2; ++hi) {
            const int hh = 2 * (wid & 1) + hi, h = 4 * g + hh;
            const bf16* pv = STATES + ((size_t)((b * 32 + c) * 32 + h) * 64) * 128;
            al[hi] = acl[hh * 128 + l]; const float el = fexp(al[hi]);
#pragma unroll
            for (int pt = 0; pt < 4; ++pt) { f32x4 yo = (f32x4){0.f, 0.f, 0.f, 0.f};
#pragma unroll
                for (int kn = 0; kn < 4; ++kn) { const bf16x8 a = __builtin_bit_cast(bf16x8, *(const u32x4*)(pv + (size_t)(16 * pt + fr) * 128 + 32 * kn + 8 * fq)); yo = mfma16(a, cf[kn], yo); }
                Y[hi][pt] = yo * el; }
            asm volatile("" ::: "memory");
        }
#pragma unroll
        for (int ss = 0; ss < 4; ++ss) {
            if (2 * ss <= lt) {
                f32x4 gq[2]; gq[0] = (f32x4){0.f, 0.f, 0.f, 0.f}; gq[1] = gq[0];
#pragma unroll
                for (int kn = 0; kn < 4; ++kn) { const bf16x8 a = *(const LAS bf16x8*)(Bs + (32 * ss + fr) * 136 + 32 * kn + 8 * fq); gq[0] = mfma16(a, cf[kn], gq[0]); }
                if (2 * ss + 1 <= lt) {
#pragma unroll
                    for (int kn = 0; kn < 4; ++kn) { const bf16x8 a = *(const LAS bf16x8*)(Bs + (32 * ss + 16 + fr) * 136 + 32 * kn + 8 * fq); gq[1] = mfma16(a, cf[kn], gq[1]); }
                }
#pragma unroll
                for (int hi = 0; hi < 2; ++hi) {
                    const int hh = 2 * (wid & 1) + hi;
                    unsigned mw[4];
#pragma unroll
                    for (int hp = 0; hp < 2; ++hp) { float v[4];
                        const f32x4 as4 = *(const LAS f32x4*)(acl + hh * 128 + 4 * fq + 32 * ss + 16 * hp), ds4 = *(const LAS f32x4*)(dtl + hh * 128 + 4 * fq + 32 * ss + 16 * hp);
#pragma unroll
                        for (int r = 0; r < 4; ++r) { const int s = 32 * ss + 16 * hp + 4 * fq + r;
                            v[r] = (s <= l) ? gq[hp][r] * fexp(al[hi] - as4[r]) * ds4[r] : 0.f; }
                        mw[2 * hp] = pk2(v[0], v[1]); mw[2 * hp + 1] = pk2(v[2], v[3]); }
                    const bf16x8 mb = __builtin_bit_cast(bf16x8, (u32x4){mw[0], mw[1], mw[2], mw[3]});
#pragma unroll
                    for (int pt = 0; pt < 4; ++pt) {
                        const LAS bf16* xp = Xs + (32 * ss + 4 * fq + ((lane >> 2) & 3)) * 264 + 64 * hh + 16 * pt + 4 * (lane & 3);
                        const bf16x8 a = cat8(ldtr(xp), ldtr(xp + 16 * 264));
                        Y[hi][pt] = mfma16(a, mb, Y[hi][pt]);
                    }
                }
            }
            asm volatile("" ::: "memory");
        }
#pragma unroll
        for (int hi = 0; hi < 2; ++hi) {
            const int hh = 2 * (wid & 1) + hi; const float dh = ssd_d[4 * g + hh];
#pragma unroll
            for (int pt = 0; pt < 4; ++pt) { const u32x2 xr = *(const LAS u32x2*)(Xs + l * 264 + 64 * hh + 16 * pt + 4 * fq);
                Y[hi][pt][0] += dh * bflo(xr.x); Y[hi][pt][1] += dh * bfhi(xr.x); Y[hi][pt][2] += dh * bflo(xr.y); Y[hi][pt][3] += dh * bfhi(xr.y); }
        }
        float q = 0.f;
#pragma unroll
        for (int hi = 0; hi < 2; ++hi) { const int hh = 2 * (wid & 1) + hi;
#pragma unroll
            for (int pt = 0; pt < 4; ++pt) { const u32x2 zr = *(const u32x2*)(PROJ + (rowbase + l) * LDP + PC_Z + 256 * g + 64 * hh + 16 * pt + 4 * fq);
                f32x4 y = Y[hi][pt]; y[0] *= silu(bflo(zr.x)); y[1] *= silu(bfhi(zr.x)); y[2] *= silu(bflo(zr.y)); y[3] *= silu(bfhi(zr.y)); Y[hi][pt] = y;
                q += (y[0] * y[0] + y[1] * y[1]) + (y[2] * y[2] + y[3] * y[3]); } }
        q += __shfl_xor(q, 16); q += __shfl_xor(q, 32);
        if (fq == 0) ssq[l * 2 + (wid & 1)] = q;
        __syncthreads();
        const float rstd = rsqrtf((ssq[l * 2] + ssq[l * 2 + 1]) * (1.0f / 256.0f) + EPS);
#pragma unroll
        for (int hi = 0; hi < 2; ++hi) { const int hh = 2 * (wid & 1) + hi;
#pragma unroll
            for (int pt = 0; pt < 4; ++pt) { const int ch = 256 * g + 64 * hh + 16 * pt + 4 * fq; const f32x4 gn = *(const f32x4*)(ssd_norm + ch); const f32x4 y = Y[hi][pt] * rstd * gn;
                u32x2 w; w.x = pk2(y[0], y[1]); w.y = pk2(y[2], y[3]);
                *(u32x2*)(PROJ + (rowbase + l) * LDP + PC_Z + ch) = w; } }
    }
}

#define XB_TMO      128
#define XB_XCNT(j)  (256  + 64 * (j))
#define XB_XSUB(j)  (1280 + 64 * (j))
#define XB_XGEN(j)  (2304 + 64 * (j))
#define XB_TOP      3328
#define XB_TOPGEN   3392
#define XCD_BAR_WORDS 3456
#define XB_SPIN_CAP (1u << 18)
__device__ __forceinline__ unsigned xb_ld(unsigned* p)              { return __hip_atomic_load(p, __ATOMIC_RELAXED, __HIP_MEMORY_SCOPE_AGENT); }
__device__ __forceinline__ unsigned xb_add(unsigned* p, unsigned v) { return __hip_atomic_fetch_add(p, v, __ATOMIC_RELAXED, __HIP_MEMORY_SCOPE_AGENT); }
__device__ __forceinline__ unsigned xb_xcc_id() { return (unsigned)__builtin_amdgcn_s_getreg((3 << 11) | 20) & 0xFu; }
#define XB_SPIN(cond, bar) do { unsigned _sp = 0; while (cond) { __builtin_amdgcn_s_sleep(1); \
    if ((++_sp & 255u) == 0u) { if (xb_ld(&(bar)[XB_TMO])) break; if (_sp > XB_SPIN_CAP) { atomicAdd(&(bar)[XB_TMO], 1u); break; } } } } while (0)
struct XcdBarrier { unsigned* bar; unsigned x; volatile LAS unsigned* st; };
__device__ __forceinline__ XcdBarrier xcd_barrier_post(unsigned* bar, volatile LAS unsigned* st) {
    XcdBarrier b; b.bar = bar; b.x = xb_xcc_id(); b.st = st;
    if (threadIdx.x == 0) (void)xb_add(&bar[XB_XCNT(b.x)], 1u);
    return b;
}
__device__ __forceinline__ void xcd_barrier_complete(unsigned* bar, unsigned x, unsigned& nloc, unsigned& nx) {
    const unsigned G = gridDim.x * gridDim.y * gridDim.z;
    unsigned sum, cnt, mine, sp = 0u;
    for (;;) {
        sum = 0u; cnt = 0u; mine = 0u;
#pragma unroll
        for (unsigned j = 0; j < 16; ++j) { const unsigned c = xb_ld(&bar[XB_XCNT(j)]); sum += c; cnt += (c > 0u) ? 1u : 0u; mine = (j == x) ? c : mine; }
        if (sum == G) break;
        __builtin_amdgcn_s_sleep(1);
        if ((++sp & 255u) == 0u) { if (xb_ld(&bar[XB_TMO])) break; if (sp > XB_SPIN_CAP) { atomicAdd(&bar[XB_TMO], 1u); break; } }
    }
    nloc = mine > 0u ? mine : 1u; nx = cnt > 0u ? cnt : 1u;
}
__device__ __forceinline__ void xcd_barrier(const XcdBarrier& b) {
    asm volatile("s_waitcnt vmcnt(0)" ::: "memory");
    __syncthreads();
    if (threadIdx.x == 0) {
        unsigned* bar = b.bar;
        __builtin_amdgcn_s_waitcnt(0);
        unsigned nloc = b.st[0], nx = b.st[1];
        if (nloc == 0u) { xcd_barrier_complete(bar, b.x, nloc, nx); b.st[0] = nloc; b.st[1] = nx; }
        const unsigned old = xb_add(&bar[XB_XSUB(b.x)], 1u);
        const unsigned gen = old / nloc;
        if (old + 1u == (gen + 1u) * nloc) {
            __builtin_amdgcn_fence(__ATOMIC_RELEASE, "agent");
            asm volatile("s_waitcnt vmcnt(0)" ::: "memory");
            const unsigned og = xb_add(&bar[XB_TOP], 1u);
            const unsigned tg = og / nx;
            if (og + 1u == (tg + 1u) * nx) xb_add(&bar[XB_TOPGEN], 1u);
            else XB_SPIN(xb_ld(&bar[XB_TOPGEN]) == tg, bar);
            __builtin_amdgcn_fence(__ATOMIC_ACQUIRE, "agent");
            xb_add(&bar[XB_XGEN(b.x)], 1u);
            asm volatile("s_waitcnt vmcnt(0)" ::: "memory");
        } else {
            XB_SPIN(xb_ld(&bar[XB_XGEN(b.x)]) == gen, bar);
            __builtin_amdgcn_fence(__ATOMIC_ACQUIRE, "agent");
            asm volatile("s_waitcnt vmcnt(0)" ::: "memory");
        }
    }
    __syncthreads();
}

struct Args { const float* in[18]; float* out; unsigned char* ws; int ph_lo, ph_hi; };
constexpr int NPH = 10;

__global__ void __launch_bounds__(512, 2) hymba_fwd(Args args) {
    extern __shared__ __attribute__((aligned(16))) unsigned char lds_raw[];
    LAS unsigned char* lds = (LAS unsigned char*)lds_raw;
    cg::grid_group grid = cg::this_grid();
    const int tid = threadIdx.x, lane = tid & 63, wid = __builtin_amdgcn_readfirstlane(tid >> 6);
    const int G = gridDim.x, bx = blockIdx.x;
    const int gw = bx * 8 + wid, NGW = G * 8;
    unsigned char* ws = args.ws;
    const float* x = args.in[0]; const float* norm_mix = args.in[1]; const float* w_in = args.in[2]; const float* sinks = args.in[3]; const float* attn_norm = args.in[4];
    const float* ssd_conv_w = args.in[5]; const float* ssd_conv_b = args.in[6]; const float* dt_bias = args.in[7]; const float* a_log = args.in[8]; const float* ssd_d = args.in[9];
    const float* ssd_norm = args.in[10]; const float* w_out = args.in[11]; const float* norm_ffn = args.in[12]; const float* w_up = args.in[13]; const float* ffn_conv_w = args.in[14];
    const float* ffn_conv_b = args.in[15]; const float* w_down = args.in[16]; const float* norm_final = args.in[17];
    float* out = args.out;
    bf16* XN = (bf16*)(ws + WS_XN); bf16* WIN = (bf16*)(ws + WS_WIN); bf16* WUP = (bf16*)(ws + WS_WUP); bf16* WDOWN = (bf16*)(ws + WS_WDOWN); bf16* WOUT = (bf16*)(ws + WS_WOUT);
    bf16* PROJ = (bf16*)(ws + WS_PROJ); bf16* ACT = (bf16*)(ws + WS_ACT); bf16* STATES = (bf16*)(ws + WS_STATES); bf16* H1B = (bf16*)(ws + WS_H1B); bf16* XCONV = (bf16*)(ws + WS_XCONV);
    float* DTRAW = (float*)(ws + WS_DTRAW); float* DTV = (float*)(ws + WS_DTV); float* ACS = (float*)(ws + WS_ACS); float* ATTSS = (float*)(ws + WS_ATTSS);
    float* SS1 = (float*)(ws + WS_SS1); float* SS2 = (float*)(ws + WS_SS2); float* HEADp = (float*)(ws + WS_HEAD); float* TAILp = (float*)(ws + WS_TAIL);
    const int lo = args.ph_lo, hi = args.ph_hi;
    unsigned* barw = (unsigned*)(ws + 4096);
    volatile LAS unsigned* xst = (volatile LAS unsigned*)(lds + 143872);
    if (tid < 2) xst[tid] = 0u;
    if (bx == 0) for (int i = tid; i < XCD_BAR_WORDS; i += 512) __hip_atomic_store(barw + i, 0u, __ATOMIC_RELAXED, __HIP_MEMORY_SCOPE_AGENT);
    XcdBarrier xbar; xbar.bar = barw; xbar.x = 0; xbar.st = xst;
#ifndef PROBE_MASK
#define PROBE_MASK 0
#endif
#if PROBE_MASK
    volatile LAS unsigned long long* tstamp = (volatile LAS unsigned long long*)(lds + 143360);
    if (tid == 0) tstamp[0] = __builtin_amdgcn_s_memrealtime();
#define STAMP(k) do { if (tid == 0) tstamp[(k) + 1] = __builtin_amdgcn_s_memrealtime(); } while (0)
#else
#define STAMP(k) do { } while (0)
#endif
#ifndef PHMASK
#define PHMASK 0x3ff
#endif
#define IN(k) (((PHMASK >> (k)) & 1) && lo <= (k) && (k) < hi)
#define SEAM(k) do { if (IN(k) && IN((k) + 1)) { \
        if ((k) == 0) { asm volatile("s_waitcnt vmcnt(0) lgkmcnt(0)" ::: "memory"); __syncthreads(); grid.sync(); \
            __builtin_amdgcn_fence(__ATOMIC_ACQUIRE, "agent"); asm volatile("s_waitcnt vmcnt(0)" ::: "memory"); __syncthreads(); \
            xbar = xcd_barrier_post(barw, xst); } \
        else { xcd_barrier(xbar); __builtin_amdgcn_fence(__ATOMIC_ACQUIRE, "agent"); asm volatile("s_waitcnt vmcnt(0)" ::: "memory"); __syncthreads(); } } } while (0)

    if (IN(0)) {
        LAS float* scr = (LAS float*)(lds + wid * 16384);
        constexpr int I_IN = 32 * (NPROJ / 32), I_OUT = 64 * 64;
        for (int it = gw; it < I_IN + I_OUT; it += NGW) {
            if (it < I_IN) { const int kb = it / (NPROJ / 32), nb = it % (NPROJ / 32), n = 32 * nb; int oc = n; bool zero = false;
                if (n < 2048) oc = n; else if (n < 4096) oc = n + 1024; else if (n < 5120) oc = n - 2048; else if (n < 9248) oc = n; else { zero = true; oc = 0; }
                transpose_item(w_in, 9248, oc, zero, nullptr, WIN, 2048, n, 64 * kb, scr, lane); }
            else { const int r = it - I_IN, kb = r / 64, nb = r % 64; transpose_item(w_out, 2048, 32 * nb, false, nullptr, WOUT, 4096, 32 * nb, 64 * kb, scr, lane); }
        }
        for (int m = gw; m < M; m += NGW) {
            const f32x4* xr = (const f32x4*)(x + (size_t)m * D) + lane; f32x4 v[8]; float s = 0.f;
#pragma unroll
            for (int j = 0; j < 8; ++j) { v[j] = xr[64 * j]; s += (v[j][0] * v[j][0] + v[j][1] * v[j][1]) + (v[j][2] * v[j][2] + v[j][3] * v[j][3]); }
            const float rstd = rsqrtf(wave_sum(s) * (1.0f / D) + EPS);
            u32x2* o8 = (u32x2*)(XN + (size_t)m * D) + lane;
#pragma unroll
            for (int j = 0; j < 8; ++j) { const f32x4 gg = *((const f32x4*)norm_mix + lane + 64 * j); u32x2 w; w.x = pk2(v[j][0] * rstd * gg[0], v[j][1] * rstd * gg[1]); w.y = pk2(v[j][2] * rstd * gg[2], v[j][3] * rstd * gg[3]); o8[64 * j] = w; }
        }
    }
    SEAM(0); STAMP(0);
    if (IN(1)) {
        pg8::Gemm g{XN, WIN, M, NPROJ, 2048, 2048}; pg8::StaticOrder S; S.init(M, NPROJ, G, bx);
        pg8::EpiProj E{PROJ, DTRAW};
        pg8::gemm_phase<pg8::EpiProj>(lds, g, S, E);
    }
    SEAM(1); STAMP(1);
    if (IN(2)) {
#ifndef P2_LIMIT
#define P2_LIMIT 1024
#endif
        for (int it = bx; it < P2_LIMIT; it += G) {
            if (it < 512) attn_item(lds, PROJ, sinks, ATTSS, it, tid, wid, lane);
            else ssd_state_item(lds, PROJ, DTRAW, ssd_conv_w, ssd_conv_b, dt_bias, a_log, XCONV, DTV, ACS, STATES, it - 512, tid, wid, lane);
        }
    }
    SEAM(2); STAMP(2);
    if (IN(3)) {
        for (int gt = bx * 512 + tid; gt < 131072; gt += G * 512) {
            const int e = gt * 4, n = e & 127, p = (e >> 7) & 63, h = (e >> 13) & 31, b = e >> 18;
            float hs[4] = {0.f, 0.f, 0.f, 0.f};
#pragma unroll 8
            for (int c = 0; c < 32; ++c) {
                u32x2* sp = (u32x2*)(STATES + ((size_t)((b * 32 + c) * 32 + h) * 64 + p) * 128 + n);
                const u32x2 sv = *sp; const float dc = fexp(ACS[((size_t)b * SEQ + 128 * c + 127) * 32 + h]);
                u32x2 w; w.x = pk2(hs[0], hs[1]); w.y = pk2(hs[2], hs[3]); *sp = w;
                hs[0] = hs[0] * dc + bflo(sv.x); hs[1] = hs[1] * dc + bfhi(sv.x); hs[2] = hs[2] * dc + bflo(sv.y); hs[3] = hs[3] * dc + bfhi(sv.y);
            }
        }
        for (int m = gw; m < M; m += NGW) {
            const float sv = lane < 32 ? ATTSS[(size_t)m * 32 + lane] : 0.f;
            const float rstd = rsqrtf(wave_sum(sv) * (1.0f / 2048.0f) + EPS);
            u32x2* o8 = (u32x2*)(PROJ + (size_t)m * LDP) + lane;
#pragma unroll
            for (int j = 0; j < 8; ++j) { const u32x2 r = o8[64 * j]; const f32x4 gg = *((const f32x4*)attn_norm + lane + 64 * j);
                u32x2 w; w.x = pk2(bflo(r.x) * rstd * gg[0], bfhi(r.x) * rstd * gg[1]); w.y = pk2(bflo(r.y) * rstd * gg[2], bfhi(r.y) * rstd * gg[3]); o8[64 * j] = w; }
        }
        LAS float* scr = (LAS float*)(lds + wid * 16384);
        constexpr int I_UP = 32 * (NUP / 32), I_DOWN = 88 * 64;
        for (int it = gw; it < I_UP + I_DOWN; it += NGW) {
            if (it < I_UP) { const int kb = it / (NUP / 32), nb = it % (NUP / 32), n = 32 * nb, pn = n >> 8, rem = n & 255, bj = rem >> 7, cc = rem & 127;
                transpose_item(w_up, NUP, bj * DFF + 128 * pn + cc, false, norm_ffn, WUP, 2048, n, 64 * kb, scr, lane); }
            else { const int r = it - I_UP, kb = r / 64, nb = r % 64; transpose_item(w_down, 2048, 32 * nb, false, nullptr, WDOWN, DFF, 32 * nb, 64 * kb, scr, lane); }
        }
    }
    SEAM(3); STAMP(3);
    if (IN(4)) {
        for (int it = bx; it < 512; it += G) ssd_out_item(lds, PROJ, XCONV, DTV, ACS, STATES, ssd_d, ssd_norm, it, tid, wid, lane);
    }
    SEAM(4); STAMP(4);
    if (IN(5)) {
        pg8::Gemm g{PROJ, WOUT, M, D, 4096, LDP}; pg8::StaticOrder S; S.init(M, D, G, bx);
        pg8::EpiRes E{x, out, H1B, SS1};
        pg8::gemm_phase<pg8::EpiRes>(lds, g, S, E);
    }
    SEAM(5); STAMP(5);
    if (IN(6)) {
        pg8::Gemm g{H1B, WUP, M, NUP, 2048, 2048}; pg8::StaticOrder S; S.init(M, NUP, G, bx);
        pg8::EpiUp E{ACT, SS1, ffn_conv_w, ffn_conv_b, HEADp, TAILp};
        pg8::gemm_phase<pg8::EpiUp>(lds, g, S, E);
    }
    SEAM(6); STAMP(6);
    if (IN(7)) {
        for (int idx = bx * 512 + tid; idx < 32 * DFF; idx += G * 512) {
            const int pm = idx / DFF, ch = idx % DFF, pn = ch >> 7, cc = ch & 127, gc = 256 * pn + cc, vc = gc + 128;
            const float* H0 = HEADp + (size_t)(pm * 2) * NUP; const float* H1 = H0 + NUP;
            float tg0 = 0.f, tg1 = 0.f, tv0 = 0.f, tv1 = 0.f;
            if ((pm & 15) != 0) { const float* T0 = TAILp + (size_t)((pm - 1) * 2) * NUP; const float* T1 = T0 + NUP; tg0 = T0[gc]; tg1 = T1[gc]; tv0 = T0[vc]; tv1 = T1[vc]; }
            const float hg0 = H0[gc], hg1 = H1[gc], hv0 = H0[vc], hv1 = H1[vc];
            const float wg0 = ffn_conv_w[ch], wg1 = ffn_conv_w[NUP + ch], wg2 = ffn_conv_w[2 * NUP + ch], bg = ffn_conv_b[ch];
            const float wv0 = ffn_conv_w[DFF + ch], wv1 = ffn_conv_w[NUP + DFF + ch], wv2 = ffn_conv_w[2 * NUP + DFF + ch], bv = ffn_conv_b[DFF + ch];
            const float g0 = bg + wg0 * tg0 + wg1 * tg1 + wg2 * hg0, v0 = bv + wv0 * tv0 + wv1 * tv1 + wv2 * hv0;
            const float g1 = bg + wg0 * tg1 + wg1 * hg0 + wg2 * hg1, v1 = bv + wv0 * tv1 + wv1 * hv0 + wv2 * hv1;
            ACT[(size_t)(256 * pm) * DFF + ch] = (bf16)f2bf(silu(g0) * v0); ACT[(size_t)(256 * pm + 1) * DFF + ch] = (bf16)f2bf(silu(g1) * v1);
        }
    }
    SEAM(7); STAMP(7);
    if (IN(8)) {
        pg8::Gemm g{ACT, WDOWN, M, D, DFF, DFF}; pg8::StaticOrder S; S.init(M, D, G, bx);
        pg8::EpiRes E{out, out, nullptr, SS2};
        pg8::gemm_phase<pg8::EpiRes>(lds, g, S, E);
    }
    SEAM(8); STAMP(8);
    if (IN(9)) {
        for (int m = gw; m < M; m += NGW) {
            const float sv = lane < 8 ? SS2[(size_t)m * 8 + lane] : 0.f;
            const float rstd = rsqrtf(wave_sum(sv) * (1.0f / D) + EPS);
            f32x4* o = (f32x4*)(out + (size_t)m * D) + lane;
#pragma unroll
            for (int j = 0; j < 8; ++j) { const f32x4 gg = *((const f32x4*)norm_final + lane + 64 * j); o[64 * j] = o[64 * j] * rstd * gg; }
        }
    }
#if PROBE_MASK
    if (tid == 0) {
        tstamp[10] = __builtin_amdgcn_s_memrealtime();
        unsigned long long d = 0;
        for (int k = 0; k < 10; ++k) if ((PROBE_MASK >> k) & 1) d += tstamp[k + 1] - tstamp[k];
        const unsigned long long t0 = __builtin_amdgcn_s_memrealtime();
        while (__builtin_amdgcn_s_memrealtime() - t0 < d) __builtin_amdgcn_s_sleep(8);
    }
    __syncthreads();
#endif
#undef IN
#undef SEAM
}

#ifdef DEBUG_STOP
__device__ __forceinline__ float dbg_san(float v) { if (!(v == v) || fabsf(v) > 1e30f) return 7.0f; return fminf(fmaxf(v, -1e4f), 1e4f); }
__global__ void dbg_digest(const unsigned short* ws16, float* out, int use_out) {
    const size_t n = (size_t)(WS_END - MiB) / 2;
    for (size_t i = (size_t)blockIdx.x * blockDim.x + threadIdx.x; i < (size_t)M * D; i += (size_t)gridDim.x * blockDim.x) {
        float acc = 0.f;
        for (int k = 0; k < 11; ++k) { const size_t idx = i + (size_t)k * 16777216u; if (idx < n) acc += dbg_san(__builtin_bit_cast(float, (unsigned)ws16[idx] << 16)); }
        if (use_out) acc += dbg_san(out[i]);
        out[i] = acc;
    }
}
#endif
extern "C" void kernel_launch(void* const* d_in, const int* in_sizes, int n_in, void* d_out, int out_size, void* d_ws, size_t ws_size, hipStream_t stream) {
    static int grid = 0;
    if (grid == 0) {
        if (n_in != 18 || out_size != M * D || ws_size < WS_END) { fprintf(stderr, "kernel_launch: unexpected shapes / workspace (n_in %d out %d ws %zu)\n", n_in, out_size, ws_size); grid = -1; return; }
        int dev = 0, cus = 0, per_cu = 0;
        if (hipGetDevice(&dev) != hipSuccess || hipDeviceGetAttribute(&cus, hipDeviceAttributeMultiprocessorCount, dev) != hipSuccess) { grid = -1; return; }
        if (hipFuncSetAttribute((const void*)hymba_fwd, hipFuncAttributeMaxDynamicSharedMemorySize, LDS_BYTES) != hipSuccess) { fprintf(stderr, "kernel_launch: hipFuncSetAttribute failed\n"); grid = -1; return; }
        if (hipOccupancyMaxActiveBlocksPerMultiprocessor(&per_cu, (const void*)hymba_fwd, 512, LDS_BYTES) != hipSuccess || per_cu < 1) { fprintf(stderr, "kernel_launch: occupancy query says %d\n", per_cu); (void)hipGetLastError(); per_cu = 1; }
        grid = cus * 1;
    }
    if (grid < 0) return;
    Args a{};
    for (int i = 0; i < 18; ++i) a.in[i] = (const float*)d_in[i];
    a.out = (float*)d_out; a.ws = (unsigned char*)d_ws;
#ifndef N_LAUNCH_SPLIT
#define N_LAUNCH_SPLIT 1
#endif
#ifdef DEBUG_STOP
    for (int p = 0; p <= DEBUG_STOP; ++p) {
#else
    for (int p = 0; p < (N_LAUNCH_SPLIT > 1 ? NPH : 1); ++p) {
#endif
        a.ph_lo = (N_LAUNCH_SPLIT > 1) ? p : 0; a.ph_hi = (N_LAUNCH_SPLIT > 1) ? p + 1 : NPH;
        void* params[] = {&a};
        hipError_t e = hipLaunchCooperativeKernel((const void*)hymba_fwd, dim3(grid), dim3(512), params, LDS_BYTES, stream);
        if (e != hipSuccess) fprintf(stderr, "kernel_launch: cooperative launch failed: %s (grid %d)\n", hipGetErrorString(e), grid);
    }
#ifdef DEBUG_STOP
    dbg_digest<<<2048, 256, 0, stream>>>((const unsigned short*)((unsigned char*)d_ws + MiB), (float*)d_out, DEBUG_STOP >= 5 ? 1 : 0);
#endif
}
```

```cpp
#include <hip/hip_runtime.h>
#include <hip/hip_cooperative_groups.h>
#include <cstdio>
#include <cstdint>
namespace cg = cooperative_groups;

#define LAS __attribute__((address_space(3)))
typedef unsigned short bf16;
typedef short bf16x8 __attribute__((ext_vector_type(8)));
typedef short s16x4 __attribute__((ext_vector_type(4)));
typedef float f32x4 __attribute__((ext_vector_type(4)));
typedef unsigned u32x4 __attribute__((ext_vector_type(4)));
typedef unsigned u32x2 __attribute__((ext_vector_type(2)));

constexpr int SEQ = 4096, M = 8192, D = 2048;
constexpr int NPROJ = 9472;
constexpr int LDP = 9216;
constexpr int PC_Z = 2048, PC_K = 4096, PC_V = 4608, PC_X = 5120;
constexpr int DFF = 5632, NUP = 11264;
constexpr float EPS = 1e-6f;
constexpr float LOG2E = 1.4426950408889634f;

constexpr size_t MiB = 1u << 20;
constexpr size_t WS_XN = 1 * MiB;
constexpr size_t WS_WIN = 33 * MiB;
constexpr size_t WS_WUP = 1 * MiB, WS_WDOWN = 45 * MiB;
constexpr size_t WS_WOUT = 70 * MiB;
constexpr size_t WS_PROJ = 86 * MiB;
constexpr size_t WS_ACT = 86 * MiB;
constexpr size_t WS_STATES = 230 * MiB;
constexpr size_t WS_H1B = 230 * MiB;
constexpr size_t WS_XCONV = 262 * MiB;
constexpr size_t WS_DTRAW = 326 * MiB;
constexpr size_t WS_DTV = 327 * MiB;
constexpr size_t WS_ACS = 328 * MiB;
constexpr size_t WS_ATTSS = 329 * MiB;
constexpr size_t WS_SS1 = 330 * MiB;
constexpr size_t WS_SS2 = 330 * MiB + 512 * 1024;
constexpr size_t WS_HEAD = 331 * MiB;
constexpr size_t WS_TAIL = 334 * MiB;
constexpr size_t WS_END = 337 * MiB;

constexpr int LDS_BYTES = 147456;
constexpr int LDS_XCH = 131072;
constexpr int LDS_RED = 139264;

__device__ __forceinline__ unsigned f2bf(float f) { unsigned u = __builtin_bit_cast(unsigned, f); return (u + 0x7fffu + ((u >> 16) & 1u)) >> 16; }
typedef float f32x2_t __attribute__((ext_vector_type(2)));
typedef __bf16 bf16x2_t __attribute__((ext_vector_type(2)));
__device__ __forceinline__ unsigned pk2(float lo, float hi) { const f32x2_t v = {lo, hi}; return __builtin_bit_cast(unsigned, __builtin_convertvector(v, bf16x2_t)); }
__device__ __forceinline__ float bflo(unsigned w) { return __builtin_bit_cast(float, w << 16); }
__device__ __forceinline__ float bfhi(unsigned w) { return __builtin_bit_cast(float, w & 0xffff0000u); }
__device__ __forceinline__ float fexp2(float x) { return __builtin_amdgcn_exp2f(x); }
__device__ __forceinline__ float fexp(float x) { return __builtin_amdgcn_exp2f(x * LOG2E); }
__device__ __forceinline__ float frcp(float x) { return __builtin_amdgcn_rcpf(x); }
__device__ __forceinline__ float silu(float v) { return v * frcp(1.0f + fexp(-v)); }
__device__ __forceinline__ float wave_sum(float v) {
#pragma unroll
    for (int o = 1; o < 64; o <<= 1) v += __shfl_xor(v, o);
    return v;
}
__device__ __forceinline__ f32x4 mfma16(bf16x8 a, bf16x8 b, f32x4 c) { return __builtin_amdgcn_mfma_f32_16x16x32_bf16(a, b, c, 0, 0, 0); }
__device__ __forceinline__ s16x4 ldtr(const LAS bf16* p) { return __builtin_amdgcn_ds_read_tr16_b64_v4i16((LAS s16x4*)p); }
__device__ __forceinline__ bf16x8 cat8(s16x4 a, s16x4 b) { return __builtin_shufflevector(a, b, 0, 1, 2, 3, 4, 5, 6, 7); }
__device__ __forceinline__ float ror1(float x) { return __builtin_bit_cast(float, __builtin_amdgcn_update_dpp(0, __builtin_bit_cast(int, x), 0x121, 0xF, 0xF, false)); }
__device__ __forceinline__ float ror2(float x) { return __builtin_bit_cast(float, __builtin_amdgcn_update_dpp(0, __builtin_bit_cast(int, x), 0x122, 0xF, 0xF, false)); }
#define LDS_WAIT() asm volatile("s_waitcnt lgkmcnt(0)" ::: "memory")
#define WG_BAR() do { asm volatile("s_waitcnt lgkmcnt(0)" ::: "memory"); __builtin_amdgcn_s_barrier(); asm volatile("" ::: "memory"); } while (0)

__device__ __forceinline__ float rope_rev(int i) {
    return i == 0 ? 0.15915494309189535f : i == 1 ? 0.03086376340470123f : i == 2 ? 0.005985185712713705f : i == 3 ? 0.001160663641240061f :
           i == 4 ? 0.00022507907903927653f : i == 5 ? 4.364795279280289e-05f : i == 6 ? 8.464330808241401e-06f : 1.6414262627950345e-06f;
}
__device__ __forceinline__ void rope_sc(float pos, int i, float& s, float& c) {
    float r = pos * rope_rev(i); r = r - floorf(r);
    s = __builtin_amdgcn_sinf(r); c = __builtin_amdgcn_cosf(r);
}

namespace pg8 {
constexpr int BM = 256, BK = 64, HALF = 128, HTB = HALF * BK * 2, NXCD = 8, WGM = 8;
__host__ __device__ __forceinline__ int lds_byte(int r, int c) { const int st = (r >> 4) * 2 + (c >> 5), rr = r & 15, cc = c & 31, ob = rr * 64 + cc * 2; return st * 1024 + (ob ^ (((ob >> 9) & 1) << 5)); }
__host__ __device__ __forceinline__ void stage_rc(int b, int& R, int& C) { const int st = b / 1024, sb = b % 1024, swz = sb ^ (((sb >> 9) & 1) << 5); R = (st >> 1) * 16 + swz / 64; C = (st & 1) * 32 + (swz % 64) / 2; }
__host__ __device__ __forceinline__ int perm32(int rho) { const int n = rho >> 4, i = rho & 15; return 8 * (i >> 2) + 4 * n + (i & 3); }
struct Unit { int pm, pn; };
struct Gemm { const bf16* A; const bf16* Bt; int M, N, K, lda; };
struct StaticOrder {
    int nM, nN, nwg, G, c;
    __device__ void init(int M_, int N_, int G_, int c_) { nM = M_ / BM; nN = N_ / BM; nwg = nM * nN; G = G_; c = c_; }
    __device__ bool next(int i, Unit& u) const {
        const long L = (long)i * G + c; if (L >= nwg) return false;
        int wgid = (int)L; { const int q = nwg / NXCD, r = nwg % NXCD, xcd = wgid % NXCD, off = wgid / NXCD; wgid = (xcd < r ? xcd * (q + 1) : r * (q + 1) + (xcd - r) * q) + off; }
        const int nig = WGM * nN, gid = wgid / nig, fm = gid * WGM, gsz = (nM - fm) < WGM ? (nM - fm) : WGM;
        u.pm = fm + ((wgid % nig) % gsz); u.pn = (wgid % nig) / gsz; return true;
    }
};
template <class Epi>
__device__ __forceinline__ void gemm_phase(LAS unsigned char* lds, const Gemm g, const StaticOrder& S, const Epi& E) {
    const int tid = threadIdx.x, wid = __builtin_amdgcn_readfirstlane(tid >> 6), lane = tid & 63, wr = wid >> 2, wc = wid & 3, fr = lane & 15, fq = lane >> 4;
    const int K = g.K, nt = K / BK, lda = g.lda;
    unsigned voffA[2], voffB[2];
#pragma unroll
    for (int i = 0; i < 2; ++i) { int R, C; stage_rc(tid * 16 + i * 8192, R, C); const int Rb = Epi::PERM ? ((R & ~31) + perm32(R & 31)) : R;
        voffA[i] = (unsigned)(R * lda + C) * 2u; voffB[i] = (unsigned)(Rb * K + C) * 2u; }
    const size_t kstep = (size_t)(BK * 2);
    const size_t hstepA = (size_t)HALF * lda * 2, hstepB = (size_t)HALF * K * 2;
    const size_t tstepA = 2 * hstepA, tstepB = 2 * hstepB;
    const unsigned ldsw = (unsigned)wid * 1024u;
    const int aoff = lds_byte(wr * 64 + fr, fq * 8), boff = lds_byte(wc * 32 + fr, fq * 8);
#define PG8_SA(b, h) (((b) * 2 + (h)) * HTB)
#define PG8_SB(b, h) ((4 + (b) * 2 + (h)) * HTB)
#define PG8_STAGE(bufoff, gbase, voff) do { _Pragma("unroll") for (int _i = 0; _i < 2; ++_i) \
        __builtin_amdgcn_global_load_lds((const unsigned*)((const char*)(gbase) + (voff)[_i]), (LAS unsigned*)(lds + (bufoff) + ldsw + _i * 8192), 16, 0, 0); } while (0)
#define PG8_LDA(dst, b, h) do { _Pragma("unroll") for (int m = 0; m < 4; ++m) _Pragma("unroll") for (int k = 0; k < 2; ++k) dst[m][k] = *(const LAS bf16x8*)(lds + PG8_SA(b, h) + aoff + m * 2048 + k * 1024); } while (0)
#define PG8_LDB(dst, b, h) do { _Pragma("unroll") for (int n = 0; n < 2; ++n) _Pragma("unroll") for (int k = 0; k < 2; ++k) dst[n][k] = *(const LAS bf16x8*)(lds + PG8_SB(b, h) + boff + n * 2048 + k * 1024); } while (0)
#define PG8_MMA(ai, bj, At, Bt) do { __builtin_amdgcn_s_setprio(1); _Pragma("unroll") for (int m = 0; m < 4; ++m) _Pragma("unroll") for (int n = 0; n < 2; ++n) _Pragma("unroll") for (int k = 0; k < 2; ++k) \
        acc[ai][bj][m][n] = __builtin_amdgcn_mfma_f32_16x16x32_bf16(Bt[n][k], At[m][k], acc[ai][bj][m][n], 0, 0, 0); __builtin_amdgcn_s_setprio(0); } while (0)
#define PG8_WAIT_V(n) asm volatile("s_waitcnt vmcnt(" #n ")" ::: "memory")
#define PG8_WAIT_L(n) asm volatile("s_waitcnt lgkmcnt(" #n ")" ::: "memory")
#define PG8_BAR __builtin_amdgcn_s_barrier()
#define PG8_SCHED __builtin_amdgcn_sched_barrier(0)
    Unit cur, nxt; int ui = 0;
    if (!S.next(0, cur)) return;
    f32x4 acc[2][2][4][2];
#pragma unroll
    for (int a = 0; a < 2; ++a)
#pragma unroll
        for (int b = 0; b < 2; ++b)
#pragma unroll
            for (int m = 0; m < 4; ++m)
#pragma unroll
                for (int n = 0; n < 2; ++n) acc[a][b][m][n] = (f32x4){0.f, 0.f, 0.f, 0.f};
    bf16x8 At[4][2], B0[2][2], B1[2][2];
    const char* cA = (const char*)g.A + (size_t)cur.pm * tstepA; const char* cB = (const char*)g.Bt + (size_t)cur.pn * tstepB;
    PG8_STAGE(PG8_SB(0, 0), cB, voffB); PG8_STAGE(PG8_SB(0, 1), cB + hstepB, voffB); PG8_STAGE(PG8_SA(0, 0), cA, voffA); PG8_STAGE(PG8_SA(0, 1), cA + hstepA, voffA);
    if (wr == 1) PG8_BAR;
    PG8_WAIT_V(2); PG8_BAR;
    PG8_STAGE(PG8_SB(1, 0), cB + kstep, voffB); PG8_STAGE(PG8_SA(1, 0), cA + kstep, voffA); PG8_STAGE(PG8_SB(1, 1), cB + hstepB + kstep, voffB);
    PG8_WAIT_V(6); PG8_BAR;
    for (;;) {
        const bool has_next = S.next(ui + 1, nxt);
        const char* nA = has_next ? (const char*)g.A + (size_t)nxt.pm * tstepA : cA; const char* nB = has_next ? (const char*)g.Bt + (size_t)nxt.pn * tstepB : cB;
        for (int t = 0; t < nt; t += 2) {
            const bool last = (t == nt - 2);
            const char* a1 = cA + (size_t)(t + 1) * kstep;
            const char* a2 = last ? nA : cA + (size_t)(t + 2) * kstep; const char* b2 = last ? nB : cB + (size_t)(t + 2) * kstep;
            const char* a3 = a2 + kstep; const char* b3 = b2 + kstep;
            PG8_LDB(B0, 0, 0); PG8_LDB(B1, 0, 1); PG8_SCHED; PG8_LDA(At, 0, 0); PG8_STAGE(PG8_SA(1, 1), a1 + hstepA, voffA);
            PG8_WAIT_V(8); PG8_WAIT_L(0); PG8_BAR; PG8_MMA(0, 0, At, B0); PG8_MMA(0, 1, At, B1); PG8_BAR; PG8_SCHED;
            PG8_LDA(At, 0, 1); PG8_STAGE(PG8_SB(0, 0), b2, voffB); PG8_STAGE(PG8_SB(0, 1), b2 + hstepB, voffB); PG8_STAGE(PG8_SA(0, 0), a2, voffA);
            PG8_WAIT_V(8); PG8_WAIT_L(0); PG8_BAR; PG8_MMA(1, 0, At, B0); PG8_MMA(1, 1, At, B1); PG8_BAR; PG8_SCHED;
            PG8_LDB(B0, 1, 0); PG8_LDB(B1, 1, 1); PG8_SCHED; PG8_LDA(At, 1, 0); PG8_STAGE(PG8_SA(0, 1), a2 + hstepA, voffA);
            PG8_WAIT_V(8); PG8_WAIT_L(0); PG8_BAR; PG8_MMA(0, 0, At, B0); PG8_MMA(0, 1, At, B1); PG8_BAR; PG8_SCHED;
            PG8_LDA(At, 1, 1); PG8_STAGE(PG8_SB(1, 0), b3, voffB); PG8_STAGE(PG8_SB(1, 1), b3 + hstepB, voffB); PG8_STAGE(PG8_SA(1, 0), a3, voffA);
            PG8_WAIT_V(8); PG8_WAIT_L(0); PG8_BAR; PG8_MMA(1, 0, At, B0); PG8_MMA(1, 1, At, B1); PG8_BAR; PG8_SCHED;
        }
        if (wr == 0) PG8_BAR;
        E(acc, cur, wr, wc, fr, fq, lds, wid, lane);
        if (!has_next) break;
#pragma unroll
        for (int a = 0; a < 2; ++a)
#pragma unroll
            for (int b = 0; b < 2; ++b)
#pragma unroll
                for (int m = 0; m < 4; ++m)
#pragma unroll
                    for (int n = 0; n < 2; ++n) acc[a][b][m][n] = (f32x4){0.f, 0.f, 0.f, 0.f};
        cur = nxt; cA = nA; cB = nB; ++ui;
        if (wr == 1) PG8_BAR;
    }
    PG8_WAIT_V(0);
    PG8_BAR;
#undef PG8_SA
#undef PG8_SB
#undef PG8_STAGE
#undef PG8_LDA
#undef PG8_LDB
#undef PG8_MMA
#undef PG8_WAIT_V
#undef PG8_WAIT_L
#undef PG8_BAR
#undef PG8_SCHED
}

struct EpiProj {
    static constexpr bool PERM = true;
    bf16* O; float* dt;
    __device__ __forceinline__ void operator()(f32x4 (&acc)[2][2][4][2], const Unit& u, int wr, int wc, int fr_, int fq_, LAS unsigned char* lds, int wid, int lane) const {
        int fr = fr_, fq = fq_; asm volatile("" : "+v"(fr), "+v"(fq));
        const int row0 = u.pm * BM + wr * 64 + fr;
        if (u.pn < 36) {
            const int col0 = u.pn * BM + wc * 32 + 8 * fq;
#pragma unroll
            for (int ai = 0; ai < 2; ++ai)
#pragma unroll
                for (int m = 0; m < 4; ++m) { bf16* rowp = O + (size_t)(row0 + ai * HALF + m * 16) * LDP + col0;
#pragma unroll
                    for (int bj = 0; bj < 2; ++bj) { const f32x4 v0 = acc[ai][bj][m][0], v1 = acc[ai][bj][m][1];
                        u32x4 w; w.x = pk2(v0[0], v0[1]); w.y = pk2(v0[2], v0[3]); w.z = pk2(v1[0], v1[1]); w.w = pk2(v1[2], v1[3]);
                        *(u32x4*)(rowp + bj * HALF) = w; } }
        } else if (wc == 0) {
#pragma unroll
            for (int ai = 0; ai < 2; ++ai)
#pragma unroll
                for (int m = 0; m < 4; ++m) { float* rp = dt + (size_t)(row0 + ai * HALF + m * 16) * 32 + 8 * fq;
                    *(f32x4*)rp = acc[ai][0][m][0]; *(f32x4*)(rp + 4) = acc[ai][0][m][1]; }
        }
    }
};
struct EpiRes {
    static constexpr bool PERM = true;
    const float* base; float* out; bf16* outb; float* ss;
    __device__ __forceinline__ void operator()(f32x4 (&acc)[2][2][4][2], const Unit& u, int wr, int wc, int fr_, int fq_, LAS unsigned char* lds, int wid, int lane_) const {
        int fr = fr_, fq = fq_, lane = lane_; asm volatile("" : "+v"(fr), "+v"(fq), "+v"(lane));
        LAS float* RED = (LAS float*)(lds + LDS_RED);
        const int row0 = u.pm * BM + wr * 64 + fr, col0 = u.pn * BM + wc * 32 + 8 * fq;
#pragma unroll
        for (int ai = 0; ai < 2; ++ai)
#pragma unroll
            for (int m = 0; m < 4; ++m) { const size_t off = (size_t)(row0 + ai * HALF + m * 16) * D + col0; float q = 0.f;
#pragma unroll
                for (int bj = 0; bj < 2; ++bj) {
                    const f32x4 v0 = *(const f32x4*)(base + off + bj * HALF) + acc[ai][bj][m][0], v1 = *(const f32x4*)(base + off + bj * HALF + 4) + acc[ai][bj][m][1];
                    *(f32x4*)(out + off + bj * HALF) = v0; *(f32x4*)(out + off + bj * HALF + 4) = v1;
                    if (outb) { u32x4 w; w.x = pk2(v0[0], v0[1]); w.y = pk2(v0[2], v0[3]); w.z = pk2(v1[0], v1[1]); w.w = pk2(v1[2], v1[3]); *(u32x4*)(outb + off + bj * HALF) = w; }
                    q += (v0[0] * v0[0] + v0[1] * v0[1]) + (v0[2] * v0[2] + v0[3] * v0[3]) + (v1[0] * v1[0] + v1[1] * v1[1]) + (v1[2] * v1[2] + v1[3] * v1[3]); }
                q += __shfl_xor(q, 16); q += __shfl_xor(q, 32);
                if (fq == 0) RED[(ai * HALF + wr * 64 + m * 16 + fr) * 4 + wc] = q; }
        WG_BAR();
        const int tid = wid * 64 + lane;
        if (tid < 256) { const f32x4 r = *(const LAS f32x4*)(RED + tid * 4); ss[(size_t)(u.pm * BM + tid) * 8 + u.pn] = (r[0] + r[1]) + (r[2] + r[3]); }
    }
};
struct EpiUp {
    static constexpr bool PERM = false;
    bf16* ACT; const float* SS1; const float* cw; const float* cb; float* HEADp; float* TAILp;
    __device__ __forceinline__ void operator()(f32x4 (&acc)[2][2][4][2], const Unit& u, int wr, int wc, int fr_, int fq_, LAS unsigned char* lds, int wid, int lane) const {
        int fr = fr_, fq = fq_; asm volatile("" : "+v"(fr), "+v"(fq));
        LAS float* XCH = (LAS float*)(lds + LDS_XCH);
        const int row0 = u.pm * BM + wr * 64 + fr;
#pragma unroll
        for (int ai = 0; ai < 2; ++ai)
#pragma unroll
            for (int m = 0; m < 4; ++m) { const float* sp = SS1 + (size_t)(row0 + ai * HALF + m * 16) * 8; const f32x4 a = *(const f32x4*)sp, b = *(const f32x4*)(sp + 4);
                const float rs = rsqrtf(((a[0] + a[1]) + (a[2] + a[3]) + (b[0] + b[1]) + (b[2] + b[3])) * (1.0f / D) + EPS);
#pragma unroll
                for (int bj = 0; bj < 2; ++bj)
#pragma unroll
                    for (int n = 0; n < 2; ++n) acc[ai][bj][m][n] = acc[ai][bj][m][n] * rs;
                if (m & 1) asm volatile("" ::: "memory"); }
        const int cl = wc * 32 + 4 * fq;
        if (fr >= 14) {
#pragma unroll
            for (int ai = 0; ai < 2; ++ai)
#pragma unroll
                for (int bj = 0; bj < 2; ++bj)
#pragma unroll
                    for (int n = 0; n < 2; ++n) *(LAS f32x4*)(XCH + ((2 * ai + wr) * 2 + (fr - 14)) * 256 + bj * HALF + n * 16 + cl) = acc[ai][bj][3][n];
            if (wr == 1) {
#pragma unroll
                for (int bj = 0; bj < 2; ++bj)
#pragma unroll
                    for (int n = 0; n < 2; ++n) *(f32x4*)(TAILp + (size_t)(u.pm * 2 + (fr - 14)) * NUP + u.pn * BM + bj * HALF + n * 16 + cl) = acc[1][bj][3][n];
            }
        }
        if (fr < 2 && wr == 0) {
#pragma unroll
            for (int bj = 0; bj < 2; ++bj)
#pragma unroll
                for (int n = 0; n < 2; ++n) *(f32x4*)(HEADp + (size_t)(u.pm * 2 + fr) * NUP + u.pn * BM + bj * HALF + n * 16 + cl) = acc[0][bj][0][n];
        }
        WG_BAR();
#pragma unroll
        for (int n = 0; n < 2; ++n) {
            const int ch = u.pn * HALF + n * 16 + cl;
            const f32x4 wg0 = *(const f32x4*)(cw + ch), wg1 = *(const f32x4*)(cw + NUP + ch), wg2 = *(const f32x4*)(cw + 2 * NUP + ch), bg = *(const f32x4*)(cb + ch);
            const f32x4 wv0 = *(const f32x4*)(cw + DFF + ch), wv1 = *(const f32x4*)(cw + NUP + DFF + ch), wv2 = *(const f32x4*)(cw + 2 * NUP + DFF + ch), bv = *(const f32x4*)(cb + DFF + ch);
#pragma unroll
            for (int ai = 0; ai < 2; ++ai) {
                const int pred = 2 * ai + wr - 1;
                f32x4 pg0 = (f32x4){0.f, 0.f, 0.f, 0.f}, pg1 = pg0, pv0 = pg0, pv1 = pg0;
                if (pred >= 0) { const LAS float* xp = XCH + (pred * 2) * 256 + n * 16 + cl;
                    pg0 = *(const LAS f32x4*)xp; pg1 = *(const LAS f32x4*)(xp + 256); pv0 = *(const LAS f32x4*)(xp + HALF); pv1 = *(const LAS f32x4*)(xp + 256 + HALF); }
#pragma unroll
                for (int m = 0; m < 4; ++m) {
                    const f32x4 G = acc[ai][0][m][n], V = acc[ai][1][m][n];
                    f32x4 g1, g2, v1, v2;
#pragma unroll
                    for (int j = 0; j < 4; ++j) {
                        const float a1 = ror1(G[j]), a2 = ror2(G[j]), c1 = ror1(V[j]), c2 = ror2(V[j]);
                        float h1, h2, k1, k2;
                        if (m > 0) { h1 = ror1(acc[ai][0][m > 0 ? m - 1 : 0][n][j]); h2 = ror2(acc[ai][0][m > 0 ? m - 1 : 0][n][j]); k1 = ror1(acc[ai][1][m > 0 ? m - 1 : 0][n][j]); k2 = ror2(acc[ai][1][m > 0 ? m - 1 : 0][n][j]); }
                        else { h1 = pg1[j]; h2 = (fr == 1) ? pg1[j] : pg0[j]; k1 = pv1[j]; k2 = (fr == 1) ? pv1[j] : pv0[j]; }
                        g1[j] = fr >= 1 ? a1 : h1; g2[j] = fr >= 2 ? a2 : h2; v1[j] = fr >= 1 ? c1 : k1; v2[j] = fr >= 2 ? c2 : k2;
                    }
                    const f32x4 cg_ = bg + wg0 * g2 + wg1 * g1 + wg2 * G, cv_ = bv + wv0 * v2 + wv1 * v1 + wv2 * V;
                    u32x2 w; w.x = pk2(silu(cg_[0]) * cv_[0], silu(cg_[1]) * cv_[1]); w.y = pk2(silu(cg_[2]) * cv_[2], silu(cg_[3]) * cv_[3]);
                    *(u32x2*)(ACT + (size_t)(row0 + ai * HALF + m * 16) * DFF + ch) = w;
                }
                asm volatile("" ::: "memory");
            }
        }
    }
};
}

struct TDesc { const float* src; const float* ksc; bf16* dst; int ldw, K; bool ok; };
__device__ __forceinline__ void tr_load(const TDesc& d, f32x4 (&v)[16], int lane) {
    const int kr = lane >> 4, n4 = lane & 15;
#pragma unroll
    for (int i = 0; i < 16; ++i) v[i] = d.ok ? *(const f32x4*)(d.src + (size_t)(4 * i + kr) * d.ldw + 4 * n4) : (f32x4){0.f, 0.f, 0.f, 0.f};
}
__device__ __forceinline__ void tr_store(const TDesc& d, const f32x4 (&v)[16], LAS bf16* scr, int lane) {
    const int kr = lane >> 4, n4 = lane & 15;
#pragma unroll
    for (int i = 0; i < 16; ++i) { const float sc = d.ksc ? d.ksc[4 * i + kr] : 1.f; u32x2 w; w.x = pk2(v[i][0] * sc, v[i][1] * sc); w.y = pk2(v[i][2] * sc, v[i][3] * sc);
        *(LAS u32x2*)(scr + (4 * i + kr) * 68 + 4 * n4) = w; }
    LDS_WAIT();
    const int g = lane >> 4, i15 = lane & 15, q = i15 >> 2, p = i15 & 3;
#pragma unroll
    for (int nt = 0; nt < 4; ++nt)
#pragma unroll
        for (int hf = 0; hf < 2; ++hf) { const int c = 4 * hf + g; const LAS bf16* rp = scr + (8 * c + q) * 68 + 16 * nt + 4 * p;
            const bf16x8 o = cat8(ldtr(rp), ldtr(rp + 4 * 68));
            *(bf16x8*)(d.dst + (size_t)(16 * nt + i15) * d.K + 8 * c) = o; }
    LDS_WAIT();
}
__device__ __forceinline__ TDesc mk_desc(const float* W, int ldw, int col0, int nvalid, const float* kscale, bf16* WT, int K, int rown0, int k0, int lane) {
    TDesc d; d.src = W + (size_t)k0 * ldw + col0; d.ksc = kscale ? kscale + k0 : nullptr; d.dst = WT + (size_t)rown0 * K + k0; d.ldw = ldw; d.K = K; d.ok = 4 * (lane & 15) < nvalid; return d;
}
#define TR_LOOP(NITEMS, DESC_OF) do { \
        int it_ = TR_START; f32x4 va_[16]; TDesc da_; \
        if (it_ < (NITEMS)) { da_ = DESC_OF(it_); tr_load(da_, va_, lane); } \
        while (it_ < (NITEMS)) { const int nx_ = it_ + TR_STRIDE; f32x4 vb_[16]; TDesc db_ = da_; \
            if (nx_ < (NITEMS)) { db_ = DESC_OF(nx_); tr_load(db_, vb_, lane); } \
            tr_store(da_, va_, scr, lane); \
            _Pragma("unroll") for (int i_ = 0; i_ < 16; ++i_) va_[i_] = vb_[i_]; \
            da_ = db_; it_ = nx_; } } while (0)

__device__ __forceinline__ void attn_item(LAS unsigned char* lds, bf16* PROJ, const float* sinks, float* ATTSS, int item, int tid, int wid, int lane) {
    const int kvh = item & 7, blk = (item >> 3) & 31, b = item >> 8;
    const int fr = lane & 15, fq = lane >> 4;
    LAS bf16* Ks = (LAS bf16*)lds;
    LAS bf16* Vs = (LAS bf16*)(lds + 36864);
    const size_t rowbase = (size_t)b * SEQ + 128 * blk;
    u32x4 qraw[2][2][2];
#pragma unroll
    for (int it = 0; it < 2; ++it)
#pragma unroll
        for (int jq = 0; jq < 2; ++jq) { const bf16* qp = PROJ + (rowbase + 64 * (wid & 1) + 32 * it + 16 * jq + fr) * LDP + (4 * kvh + (wid >> 1)) * 64 + 8 * fq;
            qraw[it][jq][0] = *(const u32x4*)qp; qraw[it][jq][1] = *(const u32x4*)(qp + 32); }
    __syncthreads();
#pragma unroll
    for (int i = 0; i < 2; ++i) {
        const int task = tid + 512 * i, kj = task >> 2, pc = task & 3;
        u32x4 k0 = (u32x4){0u, 0u, 0u, 0u}, k1 = k0, v0 = k0, v1 = k0;
        if (blk > 0 || kj >= 128) {
            const bf16* src = PROJ + (rowbase + kj - 128) * LDP + kvh * 64 + pc * 16;
            k0 = *(const u32x4*)(src + PC_K); k1 = *(const u32x4*)(src + PC_K + 8);
            v0 = *(const u32x4*)(src + PC_V); v1 = *(const u32x4*)(src + PC_V + 8);
            if (pc == 0) {
                const float pos = (float)(128 * blk + kj - 128);
                unsigned o0[4], o1[4];
#pragma unroll
                for (int w = 0; w < 4; ++w) {
                    float s0, c0, s1, c1; rope_sc(pos, 2 * w, s0, c0); rope_sc(pos, 2 * w + 1, s1, c1);
                    const float a0 = bflo(k0[w]), a1 = bfhi(k0[w]), b0 = bflo(k1[w]), b1 = bfhi(k1[w]);
                    o0[w] = pk2(a0 * c0 - b0 * s0, a1 * c1 - b1 * s1); o1[w] = pk2(b0 * c0 + a0 * s0, b1 * c1 + a1 * s1);
                }
                k0 = (u32x4){o0[0], o0[1], o0[2], o0[3]}; k1 = (u32x4){o1[0], o1[1], o1[2], o1[3]};
            }
        }
        *(LAS u32x4*)(Ks + kj * 72 + pc * 16) = k0; *(LAS u32x4*)(Ks + kj * 72 + pc * 16 + 8) = k1;
        *(LAS u32x4*)(Vs + kj * 72 + pc * 16) = v0; *(LAS u32x4*)(Vs + kj * 72 + pc * 16 + 8) = v1;
    }
    __syncthreads();
    const int h = 4 * kvh + (wid >> 1);
    const float sink2 = sinks[h] * LOG2E;
    const float SC = 0.125f * LOG2E;
#pragma unroll
    for (int it = 0; it < 2; ++it) {
        const int r0 = 64 * (wid & 1) + 32 * it;
        bf16x8 qf[2][2];
#pragma unroll
        for (int jq = 0; jq < 2; ++jq) {
            u32x4 q0 = qraw[it][jq][0]; const u32x4 q1 = qraw[it][jq][1];
            const float pos = (float)(128 * blk + r0 + 16 * jq + fr);
            unsigned o[4];
#pragma unroll
            for (int w = 0; w < 4; ++w) {
                const float m0 = bflo(q0[w]), m1 = bfhi(q0[w]);
                const float p0 = __shfl_xor(m0, 16), p1 = __shfl_xor(m1, 16);
                float s0, c0, s1, c1; rope_sc(pos, 2 * w, s0, c0); rope_sc(pos, 2 * w + 1, s1, c1);
                const float sg = (fq == 0) ? -1.f : 1.f;
                const float r0v = (fq < 2) ? m0 * c0 + sg * p0 * s0 : m0, r1v = (fq < 2) ? m1 * c1 + sg * p1 * s1 : m1;
                o[w] = pk2(r0v, r1v);
            }
            q0 = (u32x4){o[0], o[1], o[2], o[3]};
            qf[jq][0] = __builtin_bit_cast(bf16x8, q0); qf[jq][1] = __builtin_bit_cast(bf16x8, q1);
        }
        f32x4 st[10][2];
#pragma unroll
        for (int t = 0; t < 10; ++t) { st[t][0] = (f32x4){0.f, 0.f, 0.f, 0.f}; st[t][1] = st[t][0]; }
#pragma unroll
        for (int t = 0; t < 10; ++t)
#pragma unroll
            for (int ks = 0; ks < 2; ++ks) {
                const bf16x8 a = *(const LAS bf16x8*)(Ks + (r0 + 16 * t + fr) * 72 + 32 * ks + 8 * fq);
                st[t][0] = mfma16(a, qf[0][ks], st[t][0]); st[t][1] = mfma16(a, qf[1][ks], st[t][1]);
            }
        bf16x8 pb[2][5]; float rden[2];
#pragma unroll
        for (int jq = 0; jq < 2; ++jq) {
            const int qi = r0 + 16 * jq + fr;
            float mx = sink2;
#pragma unroll
            for (int t = 0; t < 10; ++t)
#pragma unroll
                for (int r = 0; r < 4; ++r) { const int kj = r0 + 16 * t + 4 * fq + r; const bool valid = (kj > qi) && (kj <= qi + 128) && (blk > 0 || kj >= 128);
                    const float s2 = st[t][jq][r] * SC; st[t][jq][r] = valid ? s2 : -3.0e38f; mx = fmaxf(mx, st[t][jq][r]); }
            mx = fmaxf(mx, __shfl_xor(mx, 16)); mx = fmaxf(mx, __shfl_xor(mx, 32));
            float l = 0.f;
#pragma unroll
            for (int t = 0; t < 10; ++t)
#pragma unroll
                for (int r = 0; r < 4; ++r) { const float p = fexp2(st[t][jq][r] - mx); st[t][jq][r] = p; l += p; }
            l += __shfl_xor(l, 16); l += __shfl_xor(l, 32);
            rden[jq] = frcp(l + fexp2(sink2 - mx));
#pragma unroll
            for (int s = 0; s < 5; ++s) { u32x4 w; w.x = pk2(st[2 * s][jq][0], st[2 * s][jq][1]); w.y = pk2(st[2 * s][jq][2], st[2 * s][jq][3]);
                w.z = pk2(st[2 * s + 1][jq][0], st[2 * s + 1][jq][1]); w.w = pk2(st[2 * s + 1][jq][2], st[2 * s + 1][jq][3]); pb[jq][s] = __builtin_bit_cast(bf16x8, w); }
        }
        f32x4 ot[4][2];
#pragma unroll
        for (int dt = 0; dt < 4; ++dt) { ot[dt][0] = (f32x4){0.f, 0.f, 0.f, 0.f}; ot[dt][1] = ot[dt][0]; }
#pragma unroll
        for (int s = 0; s < 5; ++s)
#pragma unroll
            for (int dt = 0; dt < 4; ++dt) {
                const LAS bf16* vp = Vs + (r0 + 32 * s + 4 * fq + ((lane >> 2) & 3)) * 72 + 16 * dt + 4 * (lane & 3);
                const bf16x8 a = cat8(ldtr(vp), ldtr(vp + 16 * 72));
                ot[dt][0] = mfma16(a, pb[0][s], ot[dt][0]); ot[dt][1] = mfma16(a, pb[1][s], ot[dt][1]);
            }
#pragma unroll
        for (int jq = 0; jq < 2; ++jq) {
            const size_t row = rowbase + r0 + 16 * jq + fr; float q = 0.f;
#pragma unroll
            for (int dt = 0; dt < 4; ++dt) { const f32x4 o = ot[dt][jq] * rden[jq];
                u32x2 w; w.x = pk2(o[0], o[1]); w.y = pk2(o[2], o[3]);
                *(u32x2*)(PROJ + row * LDP + h * 64 + 16 * dt + 4 * fq) = w;
                q += (o[0] * o[0] + o[1] * o[1]) + (o[2] * o[2] + o[3] * o[3]); }
            q += __shfl_xor(q, 16); q += __shfl_xor(q, 32);
            if (fq == 0) ATTSS[row * 32 + h] = q;
        }
    }
}

__device__ __forceinline__ void ssd_state_item(LAS unsigned char* lds, const bf16* PROJ, const float* DTRAW, const float* conv_w, const float* conv_b,
                                               const float* dt_bias, const float* a_log, bf16* XCONV, float* DTV, float* ACS, bf16* STATES, int item, int tid, int wid, int lane) {
    const int g = item & 7, c = (item >> 3) & 31, b = item >> 8;
    const int fq = lane >> 4;
    const size_t rowbase = (size_t)b * SEQ + 128 * c;
    LAS bf16* XB = (LAS bf16*)lds;
    LAS float* dtl = (LAS float*)(lds + 100352);
    LAS float* acl = dtl + 512;
    const int colx = lane < 32 ? PC_X + 256 * g + 8 * lane : (lane < 48 ? PC_X + 2048 + 128 * g + 8 * (lane - 32) : PC_X + 3072 + 128 * g + 8 * (lane - 48));
    u32x4 rawr[19];
#pragma unroll
    for (int k = 0; k < 19; ++k) { const int r = 16 * wid - 3 + k; rawr[k] = (u32x4){0u, 0u, 0u, 0u};
        if (128 * c + r >= 0) rawr[k] = *(const u32x4*)(PROJ + (size_t)((long)rowbase + r) * LDP + colx); }
    __syncthreads();
    if (wid < 4) {
        const int hh = wid, h = 4 * g + hh; const float bias = dt_bias[h], a = -fexp(a_log[h]);
        const int r = 2 * lane;
        float x0 = DTRAW[(rowbase + r) * 32 + h] + bias, x1 = DTRAW[(rowbase + r + 1) * 32 + h] + bias;
        const float v0 = fmaxf(x0, 0.f) + log1pf(__expf(-fabsf(x0))), v1 = fmaxf(x1, 0.f) + log1pf(__expf(-fabsf(x1)));
        const float d0 = v0 * a, d1 = v1 * a; float s = d0 + d1;
#pragma unroll
        for (int o = 1; o < 64; o <<= 1) { const float t = __shfl_up(s, o); if (lane >= o) s += t; }
        const float cs1 = s, cs0 = s - d1;
        dtl[r * 4 + hh] = v0; dtl[(r + 1) * 4 + hh] = v1; acl[r * 4 + hh] = cs0; acl[(r + 1) * 4 + hh] = cs1;
        DTV[(rowbase + r) * 32 + h] = v0; DTV[(rowbase + r + 1) * 32 + h] = v1; ACS[(rowbase + r) * 32 + h] = cs0; ACS[(rowbase + r + 1) * 32 + h] = cs1;
    }
    __syncthreads();
    {
        const int chx = colx - PC_X;
        float w[4][8], bia[8];
#pragma unroll
        for (int k = 0; k < 4; ++k) { const f32x4 a = *(const f32x4*)(conv_w + k * 4096 + chx), bb = *(const f32x4*)(conv_w + k * 4096 + chx + 4);
#pragma unroll
            for (int i = 0; i < 4; ++i) { w[k][i] = a[i]; w[k][4 + i] = bb[i]; } }
        { const f32x4 a = *(const f32x4*)(conv_b + chx), bb = *(const f32x4*)(conv_b + chx + 4);
#pragma unroll
            for (int i = 0; i < 4; ++i) { bia[i] = a[i]; bia[4 + i] = bb[i]; } }
        float xw[3][8];
        const int rs = 16 * wid;
#pragma unroll
        for (int k = 0; k < 3; ++k) { const u32x4 raw = rawr[k];
#pragma unroll
            for (int i = 0; i < 4; ++i) { xw[k][2 * i] = bflo(raw[i]); xw[k][2 * i + 1] = bfhi(raw[i]); } }
        const int hh = (lane >> 3) & 3;
        const float alast = acl[127 * 4 + hh];
#pragma unroll
        for (int rr = 0; rr < 16; ++rr) {
            const int r = rs + rr;
            const u32x4 raw = rawr[rr + 3];
            float cur[8], o[8];
#pragma unroll
            for (int i = 0; i < 4; ++i) { cur[2 * i] = bflo(raw[i]); cur[2 * i + 1] = bfhi(raw[i]); }
#pragma unroll
            for (int i = 0; i < 8; ++i) { const float v = bia[i] + w[0][i] * xw[0][i] + w[1][i] * xw[1][i] + w[2][i] * xw[2][i] + w[3][i] * cur[i]; o[i] = silu(v);
                xw[0][i] = xw[1][i]; xw[1][i] = xw[2][i]; xw[2][i] = cur[i]; }
            u32x4 wo; wo.x = pk2(o[0], o[1]); wo.y = pk2(o[2], o[3]); wo.z = pk2(o[4], o[5]); wo.w = pk2(o[6], o[7]);
            *(u32x4*)(XCONV + (rowbase + r) * 4096 + chx) = wo;
            if (lane < 48) {
                if (lane < 32) { const float sc = dtl[r * 4 + hh] * fexp(alast - acl[r * 4 + hh]);
                    wo.x = pk2(o[0] * sc, o[1] * sc); wo.y = pk2(o[2] * sc, o[3] * sc); wo.z = pk2(o[4] * sc, o[5] * sc); wo.w = pk2(o[6] * sc, o[7] * sc); }
                *(LAS u32x4*)(XB + r * 392 + 8 * lane) = wo;
            }
        }
    }
    __syncthreads();
#if defined(SSD_DBG) && SSD_DBG == 1
    return;
#endif
    {
        const int hh = wid >> 1, nh = wid & 1, h = 4 * g + hh;
        f32x4 acc[4][4];
#pragma unroll
        for (int i = 0; i < 4; ++i)
#pragma unroll
            for (int j = 0; j < 4; ++j) acc[i][j] = (f32x4){0.f, 0.f, 0.f, 0.f};
#pragma unroll
        for (int ks = 0; ks < 4; ++ks) {
            const LAS bf16* rp = XB + (32 * ks + 8 * fq + ((lane >> 2) & 3)) * 392 + 4 * (lane & 3);
            bf16x8 fa[4], fb[4];
#pragma unroll
            for (int i = 0; i < 4; ++i) { const LAS bf16* p = rp + 256 + 16 * (4 * nh + i); fa[i] = cat8(ldtr(p), ldtr(p + 4 * 392)); }
#pragma unroll
            for (int j = 0; j < 4; ++j) { const LAS bf16* p = rp + 64 * hh + 16 * j; fb[j] = cat8(ldtr(p), ldtr(p + 4 * 392)); }
#pragma unroll
            for (int i = 0; i < 4; ++i)
#pragma unroll
                for (int j = 0; j < 4; ++j) acc[i][j] = mfma16(fa[i], fb[j], acc[i][j]);
        }
        bf16* sp = STATES + ((size_t)((b * 32 + c) * 32 + h) * 64) * 128;
#pragma unroll
        for (int i = 0; i < 4; ++i)
#pragma unroll
            for (int j = 0; j < 4; ++j) { u32x2 w; w.x = pk2(acc[i][j][0], acc[i][j][1]); w.y = pk2(acc[i][j][2], acc[i][j][3]);
                *(u32x2*)(sp + (size_t)(16 * j + (lane & 15)) * 128 + 16 * (4 * nh + i) + 4 * fq) = w; }
    }
}

__device__ __forceinline__ void ssd_out_item(LAS unsigned char* lds, bf16* PROJ, const bf16* XCONV, const float* DTV, const float* ACS, const bf16* STATES,
                                             const float* ssd_d, const float* ssd_norm, int item, int tid, int wid, int lane) {
    const int g = item & 7, c = (item >> 3) & 31, b = item >> 8;
    const int fr = lane & 15, fq = lane >> 4;
    const int hh = wid >> 1, lh = wid & 1, h = 4 * g + hh;
    const size_t rowbase = (size_t)b * SEQ + 128 * c;
    LAS bf16* Xs = (LAS bf16*)lds;
    LAS bf16* Bs = (LAS bf16*)(lds + 67584);
    LAS bf16* Cs = (LAS bf16*)(lds + 67584 + 34816);
    LAS float* dtl = (LAS float*)(lds + 137216);
    LAS float* acl = dtl + 512;
    LAS float* ssq = acl + 512;
    bf16x8 pf[4][4];
    { const bf16* pv = STATES + ((size_t)((b * 32 + c) * 32 + h) * 64) * 128;
#pragma unroll
        for (int pt = 0; pt < 4; ++pt)
#pragma unroll
            for (int kn = 0; kn < 4; ++kn) pf[pt][kn] = __builtin_bit_cast(bf16x8, *(const u32x4*)(pv + (size_t)(16 * pt + fr) * 128 + 32 * kn + 8 * fq)); }
    __syncthreads();
    {
        u32x4 sv[16];
        const int soff = lane < 32 ? 256 * g + 8 * lane : (lane < 48 ? 2048 + 128 * g + 8 * (lane - 32) : 3072 + 128 * g + 8 * (lane - 48));
#pragma unroll
        for (int i = 0; i < 16; ++i) sv[i] = *(const u32x4*)(XCONV + (rowbase + wid + 8 * i) * 4096 + soff);
        const int row = tid >> 2, h4 = tid & 3; const float dv = DTV[(rowbase + row) * 32 + 4 * g + h4], av = ACS[(rowbase + row) * 32 + 4 * g + h4];
        LAS bf16* dst = lane < 32 ? Xs + 8 * lane : (lane < 48 ? Bs + 8 * (lane - 32) : Cs + 8 * (lane - 48));
        const int pitch = lane < 32 ? 264 : 136;
#pragma unroll
        for (int i = 0; i < 16; ++i) *(LAS u32x4*)(dst + (wid + 8 * i) * pitch) = sv[i];
        dtl[h4 * 128 + row] = dv; acl[h4 * 128 + row] = av;
    }
    __syncthreads();
    f32x4 Y[4][4];
#pragma unroll
    for (int j = 0; j < 4; ++j) {
        const int lt = (j == 0) ? lh : (j == 1) ? 3 - lh : (j == 2) ? 4 + lh : 7 - lh, l = 16 * lt + fr;
        bf16x8 cf[4];
#pragma unroll
        for (int kn = 0; kn < 4; ++kn) cf[kn] = *(const LAS bf16x8*)(Cs + l * 136 + 32 * kn + 8 * fq);
        const float el = fexp(acl[hh * 128 + l]);
#pragma unroll
        for (int pt = 0; pt < 4; ++pt) { f32x4 yo = (f32x4){0.f, 0.f, 0.f, 0.f};
#pragma unroll
            for (int kn = 0; kn < 4; ++kn) yo = mfma16(pf[pt][kn], cf[kn], yo);
            Y[j][pt] = yo * el; }
    }
    u32x2 zr[4][4];
#pragma unroll
    for (int j = 0; j < 4; ++j) {
        const int lt = (j == 0) ? lh : (j == 1) ? 3 - lh : (j == 2) ? 4 + lh : 7 - lh, l = 16 * lt + fr;
#pragma unroll
        for (int pt = 0; pt < 4; ++pt) zr[j][pt] = *(const u32x2*)(PROJ + (rowbase + l) * LDP + PC_Z + 256 * g + 64 * hh + 16 * pt + 4 * fq);
    }
#pragma unroll
    for (int j = 0; j < 4; ++j) {
        const int lt = (j == 0) ? lh : (j == 1) ? 3 - lh : (j == 2) ? 4 + lh : 7 - lh, l = 16 * lt + fr;
        bf16x8 cf[4];
#pragma unroll
        for (int kn = 0; kn < 4; ++kn) cf[kn] = *(const LAS bf16x8*)(Cs + l * 136 + 32 * kn + 8 * fq);
        const float al = acl[hh * 128 + l];
#pragma unroll
        for (int ss = 0; ss < 4; ++ss) {
            if (2 * ss <= lt) {
                f32x4 gq[2]; gq[0] = (f32x4){0.f, 0.f, 0.f, 0.f}; gq[1] = gq[0];
#pragma unroll
                for (int kn = 0; kn < 4; ++kn) { const bf16x8 a = *(const LAS bf16x8*)(Bs + (32 * ss + fr) * 136 + 32 * kn + 8 * fq); gq[0] = mfma16(a, cf[kn], gq[0]); }
                if (2 * ss + 1 <= lt) {
#pragma unroll
                    for (int kn = 0; kn < 4; ++kn) { const bf16x8 a = *(const LAS bf16x8*)(Bs + (32 * ss + 16 + fr) * 136 + 32 * kn + 8 * fq); gq[1] = mfma16(a, cf[kn], gq[1]); }
                }
                unsigned mw[4];
#pragma unroll
                for (int hp = 0; hp < 2; ++hp) { float v[4];
                    const f32x4 as4 = *(const LAS f32x4*)(acl + hh * 128 + 4 * fq + 32 * ss + 16 * hp), ds4 = *(const LAS f32x4*)(dtl + hh * 128 + 4 * fq + 32 * ss + 16 * hp);
#pragma unroll
                    for (int r = 0; r < 4; ++r) { const int s_ = 32 * ss + 16 * hp + 4 * fq + r;
                        v[r] = (s_ <= l) ? gq[hp][r] * fexp(al - as4[r]) * ds4[r] : 0.f; }
                    mw[2 * hp] = pk2(v[0], v[1]); mw[2 * hp + 1] = pk2(v[2], v[3]); }
                const bf16x8 mb = __builtin_bit_cast(bf16x8, (u32x4){mw[0], mw[1], mw[2], mw[3]});
#pragma unroll
                for (int pt = 0; pt < 4; ++pt) {
                    const LAS bf16* xp = Xs + (32 * ss + 4 * fq + ((lane >> 2) & 3)) * 264 + 64 * hh + 16 * pt + 4 * (lane & 3);
                    const bf16x8 a = cat8(ldtr(xp), ldtr(xp + 16 * 264));
                    Y[j][pt] = mfma16(a, mb, Y[j][pt]);
                }
            }
            asm volatile("" ::: "memory");
        }
    }
    const float dh = ssd_d[h];
#pragma unroll
    for (int j = 0; j < 4; ++j) {
        const int lt = (j == 0) ? lh : (j == 1) ? 3 - lh : (j == 2) ? 4 + lh : 7 - lh, l = 16 * lt + fr;
        float q = 0.f;
#pragma unroll
        for (int pt = 0; pt < 4; ++pt) { const u32x2 xr = *(const LAS u32x2*)(Xs + l * 264 + 64 * hh + 16 * pt + 4 * fq); const u32x2 z = zr[j][pt];
            f32x4 y = Y[j][pt];
            y[0] = (y[0] + dh * bflo(xr.x)) * silu(bflo(z.x)); y[1] = (y[1] + dh * bfhi(xr.x)) * silu(bfhi(z.x));
            y[2] = (y[2] + dh * bflo(xr.y)) * silu(bflo(z.y)); y[3] = (y[3] + dh * bfhi(xr.y)) * silu(bfhi(z.y));
            Y[j][pt] = y; q += (y[0] * y[0] + y[1] * y[1]) + (y[2] * y[2] + y[3] * y[3]); }
        q += __shfl_xor(q, 16); q += __shfl_xor(q, 32);
        if (fq == 0) ssq[l * 4 + hh] = q;
    }
    __syncthreads();
#pragma unroll
    for (int j = 0; j < 4; ++j) {
        const int lt = (j == 0) ? lh : (j == 1) ? 3 - lh : (j == 2) ? 4 + lh : 7 - lh, l = 16 * lt + fr;
        const f32x4 sq = *(const LAS f32x4*)(ssq + l * 4);
        const float rstd = rsqrtf(((sq[0] + sq[1]) + (sq[2] + sq[3])) * (1.0f / 256.0f) + EPS);
#pragma unroll
        for (int pt = 0; pt < 4; ++pt) { const int ch = 256 * g + 64 * hh + 16 * pt + 4 * fq; const f32x4 gn = *(const f32x4*)(ssd_norm + ch); const f32x4 y = Y[j][pt] * rstd * gn;
            u32x2 w; w.x = pk2(y[0], y[1]); w.y = pk2(y[2], y[3]);
            *(u32x2*)(PROJ + (rowbase + l) * LDP + PC_Z + ch) = w; }
    }
}

#define XB_TMO      128
#define XB_XCNT(j)  (256  + 64 * (j))
#define XB_XSUB(j)  (1280 + 64 * (j))
#define XB_XGEN(j)  (2304 + 64 * (j))
#define XB_TOP      3328
#define XB_TOPGEN   3392
#define XCD_BAR_WORDS 3456
#define XB_SPIN_CAP (1u << 18)
__device__ __forceinline__ unsigned xb_ld(unsigned* p)              { return __hip_atomic_load(p, __ATOMIC_RELAXED, __HIP_MEMORY_SCOPE_AGENT); }
__device__ __forceinline__ unsigned xb_add(unsigned* p, unsigned v) { return __hip_atomic_fetch_add(p, v, __ATOMIC_RELAXED, __HIP_MEMORY_SCOPE_AGENT); }
__device__ __forceinline__ unsigned xb_xcc_id() { return (unsigned)__builtin_amdgcn_s_getreg((3 << 11) | 20) & 0xFu; }
#define XB_SPIN(cond, bar) do { unsigned _sp = 0; while (cond) { __builtin_amdgcn_s_sleep(1); \
    if ((++_sp & 255u) == 0u) { if (xb_ld(&(bar)[XB_TMO])) break; if (_sp > XB_SPIN_CAP) { atomicAdd(&(bar)[XB_TMO], 1u); break; } } } } while (0)
struct XcdBarrier { unsigned* bar; unsigned x; volatile LAS unsigned* st; };
__device__ __forceinline__ XcdBarrier xcd_barrier_post(unsigned* bar, volatile LAS unsigned* st) {
    XcdBarrier b; b.bar = bar; b.x = xb_xcc_id(); b.st = st;
    if (threadIdx.x == 0) (void)xb_add(&bar[XB_XCNT(b.x)], 1u);
    return b;
}
__device__ __forceinline__ void xcd_barrier_complete(unsigned* bar, unsigned x, unsigned& nloc, unsigned& nx) {
    const unsigned G = gridDim.x * gridDim.y * gridDim.z;
    unsigned sum, cnt, mine, sp = 0u;
    for (;;) {
        sum = 0u; cnt = 0u; mine = 0u;
#pragma unroll
        for (unsigned j = 0; j < 16; ++j) { const unsigned c = xb_ld(&bar[XB_XCNT(j)]); sum += c; cnt += (c > 0u) ? 1u : 0u; mine = (j == x) ? c : mine; }
        if (sum == G) break;
        __builtin_amdgcn_s_sleep(1);
        if ((++sp & 255u) == 0u) { if (xb_ld(&bar[XB_TMO])) break; if (sp > XB_SPIN_CAP) { atomicAdd(&bar[XB_TMO], 1u); break; } }
    }
    nloc = mine > 0u ? mine : 1u; nx = cnt > 0u ? cnt : 1u;
}
__device__ __forceinline__ void xcd_barrier(const XcdBarrier& b) {
    asm volatile("s_waitcnt vmcnt(0)" ::: "memory");
    __syncthreads();
    if (threadIdx.x == 0) {
        unsigned* bar = b.bar;
        __builtin_amdgcn_s_waitcnt(0);
        unsigned nloc = b.st[0], nx = b.st[1];
        if (nloc == 0u) { xcd_barrier_complete(bar, b.x, nloc, nx); b.st[0] = nloc; b.st[1] = nx; }
        const unsigned old = xb_add(&bar[XB_XSUB(b.x)], 1u);
        const unsigned gen = old / nloc;
        if (old + 1u == (gen + 1u) * nloc) {
            __builtin_amdgcn_fence(__ATOMIC_RELEASE, "agent");
            asm volatile("s_waitcnt vmcnt(0)" ::: "memory");
            const unsigned og = xb_add(&bar[XB_TOP], 1u);
            const unsigned tg = og / nx;
            if (og + 1u == (tg + 1u) * nx) xb_add(&bar[XB_TOPGEN], 1u);
            else XB_SPIN(xb_ld(&bar[XB_TOPGEN]) == tg, bar);
            __builtin_amdgcn_fence(__ATOMIC_ACQUIRE, "agent");
            xb_add(&bar[XB_XGEN(b.x)], 1u);
            asm volatile("s_waitcnt vmcnt(0)" ::: "memory");
        } else {
            XB_SPIN(xb_ld(&bar[XB_XGEN(b.x)]) == gen, bar);
            __builtin_amdgcn_fence(__ATOMIC_ACQUIRE, "agent");
            asm volatile("s_waitcnt vmcnt(0)" ::: "memory");
        }
    }
    __syncthreads();
}

struct Args { const float* in[18]; float* out; unsigned char* ws; int ph_lo, ph_hi; };
constexpr int NPH = 10;

__global__ void __launch_bounds__(512, 2) hymba_fwd(Args args) {
    extern __shared__ __attribute__((aligned(16))) unsigned char lds_raw[];
    LAS unsigned char* lds = (LAS unsigned char*)lds_raw;
    cg::grid_group grid = cg::this_grid();
    const int tid = threadIdx.x, lane = tid & 63, wid = __builtin_amdgcn_readfirstlane(tid >> 6);
    const int G = gridDim.x, bx = blockIdx.x;
    const int gw = bx * 8 + wid, NGW = G * 8;
    int TR_START = gw, TR_STRIDE = NGW;
    unsigned char* ws = args.ws;
    const float* x = args.in[0]; const float* norm_mix = args.in[1]; const float* w_in = args.in[2]; const float* sinks = args.in[3]; const float* attn_norm = args.in[4];
    const float* ssd_conv_w = args.in[5]; const float* ssd_conv_b = args.in[6]; const float* dt_bias = args.in[7]; const float* a_log = args.in[8]; const float* ssd_d = args.in[9];
    const float* ssd_norm = args.in[10]; const float* w_out = args.in[11]; const float* norm_ffn = args.in[12]; const float* w_up = args.in[13]; const float* ffn_conv_w = args.in[14];
    const float* ffn_conv_b = args.in[15]; const float* w_down = args.in[16]; const float* norm_final = args.in[17];
    float* out = args.out;
    bf16* XN = (bf16*)(ws + WS_XN); bf16* WIN = (bf16*)(ws + WS_WIN); bf16* WUP = (bf16*)(ws + WS_WUP); bf16* WDOWN = (bf16*)(ws + WS_WDOWN); bf16* WOUT = (bf16*)(ws + WS_WOUT);
    bf16* PROJ = (bf16*)(ws + WS_PROJ); bf16* ACT = (bf16*)(ws + WS_ACT); bf16* STATES = (bf16*)(ws + WS_STATES); bf16* H1B = (bf16*)(ws + WS_H1B); bf16* XCONV = (bf16*)(ws + WS_XCONV);
    float* DTRAW = (float*)(ws + WS_DTRAW); float* DTV = (float*)(ws + WS_DTV); float* ACS = (float*)(ws + WS_ACS); float* ATTSS = (float*)(ws + WS_ATTSS);
    float* SS1 = (float*)(ws + WS_SS1); float* SS2 = (float*)(ws + WS_SS2); float* HEADp = (float*)(ws + WS_HEAD); float* TAILp = (float*)(ws + WS_TAIL);
    const int lo = args.ph_lo, hi = args.ph_hi;
    unsigned* barw = (unsigned*)(ws + 4096);
    volatile LAS unsigned* xst = (volatile LAS unsigned*)(lds + 143872);
    if (tid < 2) xst[tid] = 0u;
    __syncthreads();
    XcdBarrier xbar = xcd_barrier_post(barw, xst);
    if (args.ph_lo < 0) grid.sync();
#ifndef PROBE_MASK
#define PROBE_MASK 0
#endif
#if PROBE_MASK
    volatile LAS unsigned long long* tstamp = (volatile LAS unsigned long long*)(lds + 143360);
    if (tid == 0) tstamp[0] = __builtin_amdgcn_s_memrealtime();
#define STAMP(k) do { if (tid == 0) tstamp[(k) + 1] = __builtin_amdgcn_s_memrealtime(); } while (0)
#else
#define STAMP(k) do { } while (0)
#endif
#ifndef PHMASK
#define PHMASK 0x3ff
#endif
#define IN(k) (((PHMASK >> (k)) & 1) && lo <= (k) && (k) < hi)
#define SEAM(k) do { if (IN(k) && IN((k) + 1)) { xcd_barrier(xbar); __builtin_amdgcn_fence(__ATOMIC_ACQUIRE, "agent"); asm volatile("s_waitcnt vmcnt(0)" ::: "memory"); __syncthreads(); } } while (0)

    if (IN(0)) {
        LAS bf16* scr = (LAS bf16*)(lds + wid * 16384);
        constexpr int I_IN = 32 * (NPROJ / 64);
        auto desc0 = [&](int it) -> TDesc {
            const int kb = it / (NPROJ / 64), nb = it % (NPROJ / 64), n = 64 * nb; int oc = n, nv = 64;
            if (n < 2048) oc = n; else if (n < 4096) oc = n + 1024; else if (n < 5120) oc = n - 2048; else if (n < 9216) oc = n; else if (n == 9216) { oc = n; nv = 32; } else { oc = 0; nv = 0; }
            return mk_desc(w_in, 9248, oc, nv, nullptr, WIN, 2048, n, 64 * kb, lane); };
        TR_LOOP(I_IN, desc0);
        for (int m0 = gw; m0 < M; m0 += 2 * NGW) {
            const int m1 = (m0 + NGW < M) ? m0 + NGW : m0;
            const f32x4* xr0 = (const f32x4*)(x + (size_t)m0 * D) + lane; const f32x4* xr1 = (const f32x4*)(x + (size_t)m1 * D) + lane;
            f32x4 v0[8], v1[8]; float s0 = 0.f, s1 = 0.f;
#pragma unroll
            for (int j = 0; j < 8; ++j) { v0[j] = xr0[64 * j]; v1[j] = xr1[64 * j]; }
#pragma unroll
            for (int j = 0; j < 8; ++j) { s0 += (v0[j][0] * v0[j][0] + v0[j][1] * v0[j][1]) + (v0[j][2] * v0[j][2] + v0[j][3] * v0[j][3]); s1 += (v1[j][0] * v1[j][0] + v1[j][1] * v1[j][1]) + (v1[j][2] * v1[j][2] + v1[j][3] * v1[j][3]); }
            const float r0 = rsqrtf(wave_sum(s0) * (1.0f / D) + EPS), r1 = rsqrtf(wave_sum(s1) * (1.0f / D) + EPS);
            u32x2* o0 = (u32x2*)(XN + (size_t)m0 * D) + lane; u32x2* o1 = (u32x2*)(XN + (size_t)m1 * D) + lane;
#pragma unroll
            for (int j = 0; j < 8; ++j) { const f32x4 gg = *((const f32x4*)norm_mix + lane + 64 * j);
                u32x2 w; w.x = pk2(v0[j][0] * r0 * gg[0], v0[j][1] * r0 * gg[1]); w.y = pk2(v0[j][2] * r0 * gg[2], v0[j][3] * r0 * gg[3]); o0[64 * j] = w;
                u32x2 w1; w1.x = pk2(v1[j][0] * r1 * gg[0], v1[j][1] * r1 * gg[1]); w1.y = pk2(v1[j][2] * r1 * gg[2], v1[j][3] * r1 * gg[3]); o1[64 * j] = w1; }
        }
    }
    SEAM(0); STAMP(0);
    if (IN(1)) {
        pg8::Gemm g{XN, WIN, M, NPROJ, 2048, 2048}; pg8::StaticOrder S; S.init(M, NPROJ, G, bx);
        pg8::EpiProj E{PROJ, DTRAW};
        pg8::gemm_phase<pg8::EpiProj>(lds, g, S, E);
        { const int r = S.nwg % G; if (r == 0) { TR_START = gw; TR_STRIDE = NGW; } else if (bx >= r) { TR_START = (bx - r) * 8 + wid; TR_STRIDE = (G - r) * 8; } else { TR_START = 1 << 30; TR_STRIDE = NGW; }
          LAS bf16* scr = (LAS bf16*)(lds + wid * 16384);
          auto desc1 = [&](int it) -> TDesc { const int kb = it / 32, nb = it % 32; return mk_desc(w_out, 2048, 64 * nb, 64, nullptr, WOUT, 4096, 64 * nb, 64 * kb, lane); };
          TR_LOOP(64 * 32, desc1); TR_START = gw; TR_STRIDE = NGW; }
    }
    SEAM(1); STAMP(1);
    if (IN(2)) {
#ifndef P2_LIMIT
#define P2_LIMIT 1024
#endif
        for (int it = bx; it < P2_LIMIT; it += G) {
            if (it < 512) attn_item(lds, PROJ, sinks, ATTSS, it, tid, wid, lane);
            else ssd_state_item(lds, PROJ, DTRAW, ssd_conv_w, ssd_conv_b, dt_bias, a_log, XCONV, DTV, ACS, STATES, it - 512, tid, wid, lane);
        }
    }
    SEAM(2); STAMP(2);
    if (IN(3)) {
        for (int gt = bx * 512 + tid; gt < 131072; gt += G * 512) {
            const int e = gt * 4, n = e & 127, p = (e >> 7) & 63, h = (e >> 13) & 31, b = e >> 18;
            float hs[4] = {0.f, 0.f, 0.f, 0.f};
#pragma unroll
            for (int c = 0; c < 32; ++c) {
                u32x2* sp = (u32x2*)(STATES + ((size_t)((b * 32 + c) * 32 + h) * 64 + p) * 128 + n);
                const u32x2 sv = *sp; const float dc = fexp(ACS[((size_t)b * SEQ + 128 * c + 127) * 32 + h]);
                u32x2 w; w.x = pk2(hs[0], hs[1]); w.y = pk2(hs[2], hs[3]); *sp = w;
                hs[0] = hs[0] * dc + bflo(sv.x); hs[1] = hs[1] * dc + bfhi(sv.x); hs[2] = hs[2] * dc + bflo(sv.y); hs[3] = hs[3] * dc + bfhi(sv.y);
            }
        }
        for (int m = gw; m < M; m += NGW) {
            const float sv = lane < 32 ? ATTSS[(size_t)m * 32 + lane] : 0.f;
            const float rstd = rsqrtf(wave_sum(sv) * (1.0f / 2048.0f) + EPS);
            u32x2* o8 = (u32x2*)(PROJ + (size_t)m * LDP) + lane;
#pragma unroll
            for (int j = 0; j < 8; ++j) { const u32x2 r = o8[64 * j]; const f32x4 gg = *((const f32x4*)attn_norm + lane + 64 * j);
                u32x2 w; w.x = pk2(bflo(r.x) * rstd * gg[0], bfhi(r.x) * rstd * gg[1]); w.y = pk2(bflo(r.y) * rstd * gg[2], bfhi(r.y) * rstd * gg[3]); o8[64 * j] = w; }
        }
        LAS bf16* scr = (LAS bf16*)(lds + wid * 16384);
        constexpr int I_UP = 32 * (NUP / 64);
        auto desc3 = [&](int it) -> TDesc {
            const int kb = it / (NUP / 64), nb = it % (NUP / 64), n = 64 * nb, pn = n >> 8, rem = n & 255, bj = rem >> 7, cc = rem & 127;
            return mk_desc(w_up, NUP, bj * DFF + 128 * pn + cc, 64, norm_ffn, WUP, 2048, n, 64 * kb, lane); };
        TR_LOOP(I_UP, desc3);
    }
    SEAM(3); STAMP(3);
    if (IN(4)) {
        for (int it = bx; it < 512; it += G) ssd_out_item(lds, PROJ, XCONV, DTV, ACS, STATES, ssd_d, ssd_norm, it, tid, wid, lane);
    }
    SEAM(4); STAMP(4);
    if (IN(5)) {
        pg8::Gemm g{PROJ, WOUT, M, D, 4096, LDP}; pg8::StaticOrder S; S.init(M, D, G, bx);
        pg8::EpiRes E{x, out, H1B, SS1};
        pg8::gemm_phase<pg8::EpiRes>(lds, g, S, E);
    }
    SEAM(5); STAMP(5);
    if (IN(6)) {
        pg8::Gemm g{H1B, WUP, M, NUP, 2048, 2048}; pg8::StaticOrder S; S.init(M, NUP, G, bx);
        pg8::EpiUp E{ACT, SS1, ffn_conv_w, ffn_conv_b, HEADp, TAILp};
        pg8::gemm_phase<pg8::EpiUp>(lds, g, S, E);
        { const int r = S.nwg % G; if (r == 0) { TR_START = gw; TR_STRIDE = NGW; } else if (bx >= r) { TR_START = (bx - r) * 8 + wid; TR_STRIDE = (G - r) * 8; } else { TR_START = 1 << 30; TR_STRIDE = NGW; }
          LAS bf16* scr = (LAS bf16*)(lds + wid * 16384);
          auto desc6 = [&](int it) -> TDesc { const int kb = it / 32, nb = it % 32; return mk_desc(w_down, 2048, 64 * nb, 64, nullptr, WDOWN, DFF, 64 * nb, 64 * kb, lane); };
          TR_LOOP(88 * 32, desc6); TR_START = gw; TR_STRIDE = NGW; }
    }
    SEAM(6); STAMP(6);
    if (IN(7)) {
        for (int idx = bx * 512 + tid; idx < 32 * DFF; idx += G * 512) {
            const int pm = idx / DFF, ch = idx % DFF, pn = ch >> 7, cc = ch & 127, gc = 256 * pn + cc, vc = gc + 128;
            const float* H0 = HEADp + (size_t)(pm * 2) * NUP; const float* H1 = H0 + NUP;
            float tg0 = 0.f, tg1 = 0.f, tv0 = 0.f, tv1 = 0.f;
            if ((pm & 15) != 0) { const float* T0 = TAILp + (size_t)((pm - 1) * 2) * NUP; const float* T1 = T0 + NUP; tg0 = T0[gc]; tg1 = T1[gc]; tv0 = T0[vc]; tv1 = T1[vc]; }
            const float hg0 = H0[gc], hg1 = H1[gc], hv0 = H0[vc], hv1 = H1[vc];
            const float wg0 = ffn_conv_w[ch], wg1 = ffn_conv_w[NUP + ch], wg2 = ffn_conv_w[2 * NUP + ch], bg = ffn_conv_b[ch];
            const float wv0 = ffn_conv_w[DFF + ch], wv1 = ffn_conv_w[NUP + DFF + ch], wv2 = ffn_conv_w[2 * NUP + DFF + ch], bv = ffn_conv_b[DFF + ch];
            const float g0 = bg + wg0 * tg0 + wg1 * tg1 + wg2 * hg0, v0 = bv + wv0 * tv0 + wv1 * tv1 + wv2 * hv0;
            const float g1 = bg + wg0 * tg1 + wg1 * hg0 + wg2 * hg1, v1 = bv + wv0 * tv1 + wv1 * hv0 + wv2 * hv1;
            ACT[(size_t)(256 * pm) * DFF + ch] = (bf16)f2bf(silu(g0) * v0); ACT[(size_t)(256 * pm + 1) * DFF + ch] = (bf16)f2bf(silu(g1) * v1);
        }
    }
    SEAM(7); STAMP(7);
    if (IN(8)) {
        pg8::Gemm g{ACT, WDOWN, M, D, DFF, DFF}; pg8::StaticOrder S; S.init(M, D, G, bx);
        pg8::EpiRes E{out, out, nullptr, SS2};
        pg8::gemm_phase<pg8::EpiRes>(lds, g, S, E);
    }
    SEAM(8); STAMP(8);
    if (IN(9)) {
        for (int m0 = gw; m0 < M; m0 += 2 * NGW) {
            const int m1 = (m0 + NGW < M) ? m0 + NGW : m0;
            const float sv0 = lane < 8 ? SS2[(size_t)m0 * 8 + lane] : 0.f, sv1 = lane < 8 ? SS2[(size_t)m1 * 8 + lane] : 0.f;
            f32x4* o0 = (f32x4*)(out + (size_t)m0 * D) + lane; f32x4* o1 = (f32x4*)(out + (size_t)m1 * D) + lane;
            f32x4 v0[8], v1[8];
#pragma unroll
            for (int j = 0; j < 8; ++j) { v0[j] = o0[64 * j]; v1[j] = o1[64 * j]; }
            const float r0 = rsqrtf(wave_sum(sv0) * (1.0f / D) + EPS), r1 = rsqrtf(wave_sum(sv1) * (1.0f / D) + EPS);
#pragma unroll
            for (int j = 0; j < 8; ++j) { const f32x4 gg = *((const f32x4*)norm_final + lane + 64 * j); o0[64 * j] = v0[j] * r0 * gg; if (m1 != m0) o1[64 * j] = v1[j] * r1 * gg; }
        }
    }
#if PROBE_MASK
    if (tid == 0) {
        tstamp[10] = __builtin_amdgcn_s_memrealtime();
        unsigned long long d = 0;
        for (int k = 0; k < 10; ++k) if ((PROBE_MASK >> k) & 1) d += tstamp[k + 1] - tstamp[k];
        const unsigned long long t0 = __builtin_amdgcn_s_memrealtime();
        while (__builtin_amdgcn_s_memrealtime() - t0 < d) __builtin_amdgcn_s_sleep(8);
    }
    __syncthreads();
#endif
#undef IN
#undef SEAM
}

#ifdef DEBUG_STOP
__device__ __forceinline__ float dbg_san(float v) { if (!(v == v) || fabsf(v) > 1e30f) return 7.0f; return fminf(fmaxf(v, -1e4f), 1e4f); }
__global__ void dbg_digest(const unsigned short* ws16, float* out, int use_out) {
    const size_t n = (size_t)(WS_END - MiB) / 2;
    for (size_t i = (size_t)blockIdx.x * blockDim.x + threadIdx.x; i < (size_t)M * D; i += (size_t)gridDim.x * blockDim.x) {
        float acc = 0.f;
        for (int k = 0; k < 11; ++k) { const size_t idx = i + (size_t)k * 16777216u; if (idx < n) acc += dbg_san(__builtin_bit_cast(float, (unsigned)ws16[idx] << 16)); }
        if (use_out) acc += dbg_san(out[i]);
        out[i] = acc;
    }
}
#endif
extern "C" void kernel_launch(void* const* d_in, const int* in_sizes, int n_in, void* d_out, int out_size, void* d_ws, size_t ws_size, hipStream_t stream) {
    static int grid = 0;
    if (grid == 0) {
        if (n_in != 18 || out_size != M * D || ws_size < WS_END) { fprintf(stderr, "kernel_launch: unexpected shapes / workspace (n_in %d out %d ws %zu)\n", n_in, out_size, ws_size); grid = -1; return; }
        int dev = 0, cus = 0, per_cu = 0;
        if (hipGetDevice(&dev) != hipSuccess || hipDeviceGetAttribute(&cus, hipDeviceAttributeMultiprocessorCount, dev) != hipSuccess) { grid = -1; return; }
        if (hipFuncSetAttribute((const void*)hymba_fwd, hipFuncAttributeMaxDynamicSharedMemorySize, LDS_BYTES) != hipSuccess) { fprintf(stderr, "kernel_launch: hipFuncSetAttribute failed\n"); grid = -1; return; }
        if (hipOccupancyMaxActiveBlocksPerMultiprocessor(&per_cu, (const void*)hymba_fwd, 512, LDS_BYTES) != hipSuccess || per_cu < 1) { fprintf(stderr, "kernel_launch: occupancy query says %d\n", per_cu); (void)hipGetLastError(); per_cu = 1; }
        grid = cus * 1;
    }
    if (grid < 0) return;
    if (hipMemsetAsync((char*)d_ws + 4096, 0, XCD_BAR_WORDS * 4, stream) != hipSuccess) { fprintf(stderr, "kernel_launch: memset of the barrier words failed\n"); return; }
    Args a{};
    for (int i = 0; i < 18; ++i) a.in[i] = (const float*)d_in[i];
    a.out = (float*)d_out; a.ws = (unsigned char*)d_ws;
#ifndef N_LAUNCH_SPLIT
#define N_LAUNCH_SPLIT 1
#endif
#ifdef DEBUG_STOP
    for (int p = 0; p <= DEBUG_STOP; ++p) {
#else
    for (int p = 0; p < (N_LAUNCH_SPLIT > 1 ? NPH : 1); ++p) {
#endif
        a.ph_lo = (N_LAUNCH_SPLIT > 1) ? p : 0; a.ph_hi = (N_LAUNCH_SPLIT > 1) ? p + 1 : NPH;
        void* params[] = {&a};
        hipError_t e = hipLaunchCooperativeKernel((const void*)hymba_fwd, dim3(grid), dim3(512), params, LDS_BYTES, stream);
        if (e != hipSuccess) fprintf(stderr, "kernel_launch: cooperative launch failed: %s (grid %d)\n", hipGetErrorString(e), grid);
    }
#ifdef DEBUG_STOP
    dbg_digest<<<2048, 256, 0, stream>>>((const unsigned short*)((unsigned char*)d_ws + MiB), (float*)d_out, DEBUG_STOP >= 5 ? 1 : 0);
#endif
}
```
